# Optimizing an MI355X kernel written in HIP

```python
import jax, jax.numpy as jnp
from jax import lax
import numpy as np

D_MODEL = 1024
BATCH = 4
SEQ = 4096
DEPTH = 1

HEAD_DIM = 64
N_HEADS = D_MODEL // HEAD_DIM
N_MOBA_HEADS = N_HEADS // 2
N_FOX_HEADS = N_HEADS - N_MOBA_HEADS
MOBA_WIDTH = N_MOBA_HEADS * HEAD_DIM
FOX_WIDTH = N_FOX_HEADS * HEAD_DIM
IN_WIDTH = 3 * MOBA_WIDTH + 3 * FOX_WIDTH + N_FOX_HEADS
MOBA_BLOCK = 256
MOBA_TOPK = 3
MOBA_Q_CHUNK = 32
FOX_Q_BLOCK = 128
ROPE_THETA = 500000.0
ROPE_DIM = HEAD_DIM // 4
D_FF = 4 * D_MODEL
EPS = 1e-6

kernel_name = "hymba_moba_fox_sqrelu_adaln"


def _rms(x):
    xf = x.astype(jnp.float32)
    return xf * lax.rsqrt(jnp.mean(xf * xf, axis=-1, keepdims=True) + EPS)


def _head_norm(x, gain):
    return (_rms(x) * gain.astype(jnp.float32)).astype(x.dtype)


def _partial_rope(x):
    S = x.shape[2]
    half = ROPE_DIM // 2
    inv_freq = ROPE_THETA ** (-jnp.arange(0, ROPE_DIM, 2, dtype=jnp.float32) / ROPE_DIM)
    ang = jnp.arange(S, dtype=jnp.float32)[:, None] * inv_freq[None, :]
    cos, sin = jnp.cos(ang), jnp.sin(ang)
    xr = x[..., :ROPE_DIM].astype(jnp.float32)
    x1, x2 = xr[..., :half], xr[..., half:]
    rot = jnp.concatenate([x1 * cos - x2 * sin, x2 * cos + x1 * sin], axis=-1)
    return jnp.concatenate([rot.astype(x.dtype), x[..., ROPE_DIM:]], axis=-1)


def _split_heads(t, n_heads):
    B, S, _ = t.shape
    return t.reshape(B, S, n_heads, HEAD_DIM).transpose(0, 2, 1, 3)


def _merge_heads(t):
    B, H, S, d = t.shape
    return t.transpose(0, 2, 1, 3).reshape(B, S, H * d)


def moba_attention(q, k, v):
    B, H, S, d = q.shape
    nb = -(-S // MOBA_BLOCK)
    s_pad = nb * MOBA_BLOCK
    pad = ((0, 0), (0, 0), (0, s_pad - S), (0, 0))
    q, k, v = jnp.pad(q, pad), jnp.pad(k, pad), jnp.pad(v, pad)
    kb = k.reshape(B, H, nb, MOBA_BLOCK, d)
    vb = v.reshape(B, H, nb, MOBA_BLOCK, d)
    k_mean = jnp.mean(kb.astype(jnp.float32), axis=3)
    t_blk = jnp.arange(s_pad) // MOBA_BLOCK
    gate = jnp.einsum('bhtd,bhnd->bhtn', q.astype(jnp.float32), k_mean)
    fully_past = jnp.arange(nb)[None, :] < t_blk[:, None]
    gate = jnp.where(fully_past, gate, -jnp.inf)
    top_k = min(MOBA_TOPK, nb)
    _, sel = lax.top_k(gate, top_k)

    C = MOBA_Q_CHUNK
    n_chunks = s_pad // C
    q_c = q.reshape(B, H, n_chunks, C, d).transpose(2, 0, 1, 3, 4)
    sel_c = sel.reshape(B, H, n_chunks, C, top_k).transpose(2, 0, 1, 3, 4)
    b_idx = jnp.arange(B)[:, None, None, None]
    h_idx = jnp.arange(H)[None, :, None, None]
    local = jnp.arange(MOBA_BLOCK)
    scale = d ** -0.5
    n_sel = top_k * MOBA_BLOCK

    def chunk(args):
        qc, selc, ci = args
        t0 = ci * C
        blk = t0 // MOBA_BLOCK
        k_sel = kb[b_idx, h_idx, selc]
        v_sel = vb[b_idx, h_idx, selc]
        s_sel = jnp.einsum('bhtd,bhtkld->bhtkl', qc, k_sel,
                           preferred_element_type=jnp.float32) * scale
        valid = jnp.arange(top_k) < blk
        s_sel = jnp.where(valid[:, None], s_sel, -jnp.inf).reshape(B, H, C, n_sel)
        k_own = lax.dynamic_index_in_dim(kb, blk, axis=2, keepdims=False)
        v_own = lax.dynamic_index_in_dim(vb, blk, axis=2, keepdims=False)
        s_own = jnp.einsum('bhtd,bhld->bhtl', qc, k_own,
                           preferred_element_type=jnp.float32) * scale
        t_loc = t0 - blk * MOBA_BLOCK + jnp.arange(C)
        s_own = jnp.where(local[None, :] <= t_loc[:, None], s_own, -jnp.inf)
        p = jax.nn.softmax(jnp.concatenate([s_sel, s_own], axis=-1), axis=-1)
        p_sel = p[..., :n_sel].reshape(B, H, C, top_k, MOBA_BLOCK).astype(v.dtype)
        p_own = p[..., n_sel:].astype(v.dtype)
        return (jnp.einsum('bhtkl,bhtkld->bhtd', p_sel, v_sel)
                + jnp.einsum('bhtl,bhld->bhtd', p_own, v_own))

    out = lax.map(chunk, (q_c, sel_c, jnp.arange(n_chunks)))
    return out.transpose(1, 2, 0, 3, 4).reshape(B, H, s_pad, d)[:, :, :S]


def forgetting_attention(q, k, v, log_f):
    B, H, S, d = q.shape
    cum = jnp.cumsum(log_f, axis=-1)
    nq = S // FOX_Q_BLOCK
    q_b = q.reshape(B, H, nq, FOX_Q_BLOCK, d).transpose(2, 0, 1, 3, 4)
    c_b = cum.reshape(B, H, nq, FOX_Q_BLOCK).transpose(2, 0, 1, 3)
    key_pos = jnp.arange(S)
    scale = d ** -0.5

    def block(args):
        qb, cb, i = args
        s = jnp.einsum('bhtd,bhsd->bhts', qb, k, preferred_element_type=jnp.float32) * scale
        s = s + cb[..., :, None] - cum[:, :, None, :]
        q_pos = i * FOX_Q_BLOCK + jnp.arange(FOX_Q_BLOCK)
        s = jnp.where(key_pos[None, :] <= q_pos[:, None], s, -jnp.inf)
        p = jax.nn.softmax(s, axis=-1).astype(v.dtype)
        return jnp.einsum('bhts,bhsd->bhtd', p, v)

    out = lax.map(block, (q_b, c_b, jnp.arange(nq)))
    return out.transpose(1, 2, 0, 3, 4).reshape(B, H, S, d)


def setup_inputs(seed: int = 0) -> dict:
    key = jax.random.key(seed)
    ks = jax.random.split(key, 16)
    f32 = jnp.float32
    x = jax.random.normal(ks[0], (BATCH, SEQ, D_MODEL), f32)
    c = jax.random.normal(ks[1], (BATCH, D_MODEL), f32)
    w_ada = jax.random.normal(ks[2], (DEPTH, D_MODEL, 6 * D_MODEL), f32) * (0.5 * D_MODEL ** -0.5)
    b_ada = 0.01 * jax.random.normal(ks[3], (DEPTH, 6 * D_MODEL), f32)
    w_in = jax.random.normal(ks[4], (DEPTH, D_MODEL, IN_WIDTH), f32) * D_MODEL ** -0.5
    b_forget = jax.random.uniform(ks[5], (DEPTH, N_FOX_HEADS), f32, 1.0, 4.0)
    g_qn_moba = 1.0 + 0.02 * jax.random.normal(ks[6], (DEPTH, HEAD_DIM), f32)
    g_kn_moba = 1.0 + 0.02 * jax.random.normal(ks[7], (DEPTH, HEAD_DIM), f32)
    g_qn_fox = 1.0 + 0.02 * jax.random.normal(ks[8], (DEPTH, HEAD_DIM), f32)
    g_kn_fox = 1.0 + 0.02 * jax.random.normal(ks[9], (DEPTH, HEAD_DIM), f32)
    g_out_moba = 1.0 + 0.02 * jax.random.normal(ks[10], (DEPTH, MOBA_WIDTH), f32)
    g_out_fox = 1.0 + 0.02 * jax.random.normal(ks[11], (DEPTH, FOX_WIDTH), f32)
    w_out = jax.random.normal(ks[12], (DEPTH, D_MODEL, D_MODEL), f32) * D_MODEL ** -0.5
    w_ff1 = jax.random.normal(ks[13], (DEPTH, D_MODEL, D_FF), f32) * D_MODEL ** -0.5
    w_ff2 = jax.random.normal(ks[14], (DEPTH, D_FF, D_MODEL), f32) * D_FF ** -0.5
    return {"x": x, "c": c, "w_ada": w_ada, "b_ada": b_ada, "w_in": w_in, "b_forget": b_forget,
            "g_qn_moba": g_qn_moba, "g_kn_moba": g_kn_moba, "g_qn_fox": g_qn_fox, "g_kn_fox": g_kn_fox,
            "g_out_moba": g_out_moba, "g_out_fox": g_out_fox, "w_out": w_out,
            "w_ff1": w_ff1, "w_ff2": w_ff2}


def reference(x, c, w_ada, b_ada, w_in, b_forget, g_qn_moba, g_kn_moba, g_qn_fox, g_kn_fox,
              g_out_moba, g_out_fox, w_out, w_ff1, w_ff2):
    M = MOBA_WIDTH
    F = FOX_WIDTH
    for l in range(DEPTH):
        mod = jax.nn.silu(c) @ w_ada[l] + b_ada[l]
        sh_a, sc_a, g_a, sh_m, sc_m, g_m = [m[:, None, :] for m in jnp.split(mod, 6, axis=-1)]

        h = (_rms(x) * (1.0 + sc_a) + sh_a).astype(x.dtype)
        proj = h @ w_in[l]
        q_m = proj[..., 0:M]
        k_m = proj[..., M:2 * M]
        v_m = proj[..., 2 * M:3 * M]
        o0 = 3 * M
        q_f = proj[..., o0:o0 + F]
        k_f = proj[..., o0 + F:o0 + 2 * F]
        v_f = proj[..., o0 + 2 * F:o0 + 3 * F]
        f_logit = proj[..., o0 + 3 * F:]

        q_m = _partial_rope(_head_norm(_split_heads(q_m, N_MOBA_HEADS), g_qn_moba[l]))
        k_m = _partial_rope(_head_norm(_split_heads(k_m, N_MOBA_HEADS), g_kn_moba[l]))
        v_m = _split_heads(v_m, N_MOBA_HEADS)
        o_m = _merge_heads(moba_attention(q_m, k_m, v_m))

        q_f = _head_norm(_split_heads(q_f, N_FOX_HEADS), g_qn_fox[l])
        k_f = _head_norm(_split_heads(k_f, N_FOX_HEADS), g_kn_fox[l])
        v_f = _split_heads(v_f, N_FOX_HEADS)
        log_f = jax.nn.log_sigmoid(f_logit.astype(jnp.float32) + b_forget[l].astype(jnp.float32))
        o_f = _merge_heads(forgetting_attention(q_f, k_f, v_f, log_f.transpose(0, 2, 1)))

        mixed = jnp.concatenate([(_rms(o_m) * g_out_moba[l]).astype(x.dtype),
                                 (_rms(o_f) * g_out_fox[l]).astype(x.dtype)], axis=-1)
        x = x + g_a * (mixed @ w_out[l])

        h = (_rms(x) * (1.0 + sc_m) + sh_m).astype(x.dtype)
        x = x + g_m * (jnp.square(jax.nn.relu(h @ w_ff1[l])) @ w_ff2[l])
    return x
```

```cpp
#include <hip/hip_runtime.h>
#include <hip/hip_cooperative_groups.h>
#include <cstdio>
#include <cstdint>
#include <cmath>
namespace pg8 {
#define PG8_LAS __attribute__((address_space(3)))
typedef unsigned short bf16_t;
typedef short bf16x8 __attribute__((ext_vector_type(8)));
typedef float f32x4 __attribute__((ext_vector_type(4)));
typedef unsigned u32x4 __attribute__((ext_vector_type(4)));
constexpr int BM = 256, BK = 64, HALF = 128, HTB = HALF * BK * 2  , STAGE_BYTES = 8 * HTB, NXCD = 8, WGM = 8;

__host__ __device__ __forceinline__ int lds_byte(int r, int c) { const int st = (r >> 4) * 2 + (c >> 5), rr = r & 15, cc = c & 31, ob = rr * 64 + cc * 2; return st * 1024 + (ob ^ (((ob >> 9) & 1) << 5)); }
__host__ __device__ __forceinline__ void stage_rc(int b, int& R, int& C) { const int st = b / 1024, sb = b % 1024, swz = sb ^ (((sb >> 9) & 1) << 5); R = (st >> 1) * 16 + swz / 64; C = (st & 1) * 32 + (swz % 64) / 2; }
__host__ __device__ __forceinline__ int perm32(int rho) { const int n = rho >> 4, i = rho & 15; return 8 * (i >> 2) + 4 * n + (i & 3); }

struct Unit { int pm, pn; };
struct Gemm { const bf16_t* A; const bf16_t* Bt; int M, N, K; };

struct StaticOrder {
    int nM, nN, nwg, G, c;
    __host__ __device__ void init(int M, int N, int G_, int c_) { nM = M / BM; nN = N / BM; nwg = nM * nN; G = G_; c = c_; }
    __host__ __device__ bool next(int i, Unit& u) const {
        const long L = (long)i * G + c; if (L >= nwg) return false;
        int wgid = (int)L; { const int q = nwg / NXCD, r = nwg % NXCD, xcd = wgid % NXCD, off = wgid / NXCD; wgid = (xcd < r ? xcd * (q + 1) : r * (q + 1) + (xcd - r) * q) + off; }
        const int nig = WGM * nN, gid = wgid / nig, fm = gid * WGM, gsz = (nM - fm) < WGM ? (nM - fm) : WGM;
        u.pm = fm + ((wgid % nig) % gsz); u.pn = (wgid % nig) / gsz; return true;
    }
    __device__ __forceinline__ void a_ready(const Unit&) const {}
    __device__ __forceinline__ void done(const Unit&) const {}
};

__device__ __forceinline__ unsigned cvt_pk_bf16(float lo, float hi) { unsigned r; asm volatile("v_cvt_pk_bf16_f32 %0, %1, %2" : "=v"(r) : "v"(lo), "v"(hi)); return r; }
typedef float f32x2 __attribute__((ext_vector_type(2)));

constexpr float kEPS = 1e-6f;
constexpr float kQSCALE = 0.125f * 1.4426950408889634f;
#define PG8_LWAIT() asm volatile("s_waitcnt lgkmcnt(0)" ::: "memory")

struct EpiQKV {
    static constexpr bool PERM = true, AFTER_DRAIN = false, HAS_MID = false;
    bf16_t* O; const float* gains; const float* rope; PG8_LAS float* xch;
    __device__ __forceinline__ void operator()(f32x4 (&acc)[2][2][4][2], const Unit& u, int wr, int wc, int fr_in, int fq_in) const {
        int fr = fr_in, fq = fq_in; asm volatile("" : "+v"(fr), "+v"(fq));
        const int seg = u.pn >> 1;
        const int row0 = u.pm * BM + wr * 64 + fr, col0 = u.pn * BM + wc * 32 + 8 * fq;
        const bool normed = (seg != 2) && (seg != 5);
        if (normed) {
#pragma unroll
            for (int ai = 0; ai < 2; ++ai)
#pragma unroll
                for (int m = 0; m < 4; ++m)
#pragma unroll
                    for (int bj = 0; bj < 2; ++bj) {
                        const f32x4 a = acc[ai][bj][m][0], b = acc[ai][bj][m][1];
                        float s = (a[0] * a[0] + a[1] * a[1]) + (a[2] * a[2] + a[3] * a[3]) + (b[0] * b[0] + b[1] * b[1]) + (b[2] * b[2] + b[3] * b[3]);
                        s += __shfl_xor(s, 16); s += __shfl_xor(s, 32);
                        if (fq == 0) xch[(ai * HALF + wr * 64 + m * 16 + fr) * 8 + (2 * bj + (wc >> 1)) * 2 + (wc & 1)] = s;
                    }
            PG8_LWAIT(); __builtin_amdgcn_s_barrier(); asm volatile("" ::: "memory");
            const float* gp = gains + 64 * ((seg == 0) ? 0 : (seg == 1) ? 1 : (seg == 3) ? 2 : 3);
            const int d0 = 32 * (wc & 1) + 8 * fq;
            const f32x4 g0 = *(const f32x4*)(gp + d0), g1 = *(const f32x4*)(gp + d0 + 4);
            const float qs = (seg == 0 || seg == 3) ? kQSCALE : 1.f;
            const bool do_rope = (seg < 2) && ((wc & 1) == 0);
#pragma unroll
            for (int ai = 0; ai < 2; ++ai)
#pragma unroll
                for (int m = 0; m < 4; ++m) {
                    const int rl = ai * HALF + wr * 64 + m * 16 + fr;
                    f32x4 c0 = {1.f, 1.f, 1.f, 1.f}, c1 = c0, s0 = {0.f, 0.f, 0.f, 0.f}, s1 = s0;
                    if (do_rope) {
                        const int t = (u.pm * BM + rl) & 4095;
                        const f32x4* rp = (const f32x4*)(rope + (size_t)t * 16);
                        c0 = rp[0]; c1 = rp[1]; s0 = rp[2]; s1 = rp[3];
                    }
#pragma unroll
                    for (int bj = 0; bj < 2; ++bj) {
                        const PG8_LAS float* xp = xch + rl * 8 + (2 * bj + (wc >> 1)) * 2;
                        const float rsq = __builtin_amdgcn_rsqf((xp[0] + xp[1]) * (1.0f / 64.0f) + kEPS);
                        f32x4 v0 = acc[ai][bj][m][0] * rsq * g0, v1 = acc[ai][bj][m][1] * rsq * g1;
                        if (do_rope) {
                            f32x4 p0, p1;
#pragma unroll
                            for (int e = 0; e < 4; ++e) { p0[e] = __shfl_xor(v0[e], 16); p1[e] = __shfl_xor(v1[e], 16); }
                            const float sg = (fq == 0) ? -1.f : 1.f;
                            if (fq < 2) { v0 = v0 * c0 + p0 * s0 * sg; v1 = v1 * c1 + p1 * s1 * sg; }
                        }
                        v0 = v0 * qs; v1 = v1 * qs;
                        u32x4 w; w.x = cvt_pk_bf16(v0[0], v0[1]); w.y = cvt_pk_bf16(v0[2], v0[3]); w.z = cvt_pk_bf16(v1[0], v1[1]); w.w = cvt_pk_bf16(v1[2], v1[3]);
                        *(u32x4*)(O + (size_t)(row0 + ai * HALF + m * 16) * 3072 + col0 + bj * HALF) = w;
                    }
                    asm volatile("" ::: "memory");
                }
        } else {
#pragma unroll
            for (int ai = 0; ai < 2; ++ai)
#pragma unroll
                for (int m = 0; m < 4; ++m)
#pragma unroll
                    for (int bj = 0; bj < 2; ++bj) {
                        const f32x4 v0 = acc[ai][bj][m][0], v1 = acc[ai][bj][m][1];
                        u32x4 w; w.x = cvt_pk_bf16(v0[0], v0[1]); w.y = cvt_pk_bf16(v0[2], v0[3]); w.z = cvt_pk_bf16(v1[0], v1[1]); w.w = cvt_pk_bf16(v1[2], v1[3]);
                        *(u32x4*)(O + (size_t)(row0 + ai * HALF + m * 16) * 3072 + col0 + bj * HALF) = w;
                    }
        }
    }
};

struct EpiRelu2 {
    static constexpr bool PERM = true, AFTER_DRAIN = false, HAS_MID = false;
    bf16_t* O; int ldc;
    __device__ __forceinline__ void operator()(f32x4 (&acc)[2][2][4][2], const Unit& u, int wr, int wc, int fr_in, int fq_in) const {
        int fr = fr_in, fq = fq_in; asm volatile("" : "+v"(fr), "+v"(fq));
        const int row0 = u.pm * BM + wr * 64 + fr, col0 = u.pn * BM + wc * 32 + 8 * fq;
#pragma unroll
        for (int ai = 0; ai < 2; ++ai)
#pragma unroll
            for (int m = 0; m < 4; ++m)
#pragma unroll
                for (int bj = 0; bj < 2; ++bj) {
                    f32x4 v0 = acc[ai][bj][m][0], v1 = acc[ai][bj][m][1];
#pragma unroll
                    for (int e = 0; e < 4; ++e) { const float a = fmaxf(v0[e], 0.f), b = fmaxf(v1[e], 0.f); v0[e] = a * a; v1[e] = b * b; }
                    u32x4 w; w.x = cvt_pk_bf16(v0[0], v0[1]); w.y = cvt_pk_bf16(v0[2], v0[3]); w.z = cvt_pk_bf16(v1[0], v1[1]); w.w = cvt_pk_bf16(v1[2], v1[3]);
                    *(u32x4*)(O + (size_t)(row0 + ai * HALF + m * 16) * ldc + col0 + bj * HALF) = w;
                }
    }
};

struct EpiOut {
    static constexpr bool PERM = false, AFTER_DRAIN = false, HAS_MID = true;
    const float* x; float* x1; const float* ga; float* ssq2; const PG8_LAS float* tab;
    __device__ __forceinline__ void mid(f32x4 (&acc)[2][2][4][2], int wr, int fr_in) const {
        int fr = fr_in; asm volatile("" : "+v"(fr));
#pragma unroll
        for (int ai = 0; ai < 2; ++ai)
#pragma unroll
            for (int m = 0; m < 4; ++m) { const float r = tab[ai * HALF + wr * 64 + m * 16 + fr];
#pragma unroll
                for (int bj = 0; bj < 2; ++bj) { acc[ai][bj][m][0] *= r; acc[ai][bj][m][1] *= r; } }
    }
    __device__ __forceinline__ void operator()(f32x4 (&acc)[2][2][4][2], const Unit& u, int wr, int wc, int fr_in, int fq_in) const {
        int fr = fr_in, fq = fq_in; asm volatile("" : "+v"(fr), "+v"(fq));
        const int col0 = u.pn * BM + wc * 32 + 4 * fq; const float* gab = ga + (size_t)(u.pm >> 4) * 6144;
        f32x4 gv[2][2];
#pragma unroll
        for (int bj = 0; bj < 2; ++bj)
#pragma unroll
            for (int n = 0; n < 2; ++n) gv[bj][n] = *(const f32x4*)(gab + col0 + bj * HALF + n * 16);
#pragma unroll
        for (int ai = 0; ai < 2; ++ai)
#pragma unroll
            for (int m = 0; m < 4; ++m) { const int rl = ai * HALF + wr * 64 + m * 16 + fr; const float rf = tab[256 + rl]; const size_t off = (size_t)(u.pm * BM + rl) * 1024 + col0; float s = 0.f;
#pragma unroll
                for (int bj = 0; bj < 2; ++bj)
#pragma unroll
                    for (int n = 0; n < 2; ++n) { const f32x4 xs = *(const f32x4*)(x + off + bj * HALF + n * 16); const f32x4 o = xs + gv[bj][n] * (acc[ai][bj][m][n] * rf);
                        s += (o[0] * o[0] + o[1] * o[1]) + (o[2] * o[2] + o[3] * o[3]); *(f32x4*)(x1 + off + bj * HALF + n * 16) = o; }
                s += __shfl_xor(s, 16); s += __shfl_xor(s, 32);
                if (fq == 0) atomicAdd(ssq2 + u.pm * BM + rl, s);
                asm volatile("" ::: "memory"); }
    }
};

struct EpiFinal {
    static constexpr bool PERM = false, AFTER_DRAIN = false, HAS_MID = false;
    const float* x1; float* out; const float* gm;
    __device__ __forceinline__ void operator()(f32x4 (&acc)[2][2][4][2], const Unit& u, int wr, int wc, int fr_in, int fq_in) const {
        int fr = fr_in, fq = fq_in; asm volatile("" : "+v"(fr), "+v"(fq));
        const int col0 = u.pn * BM + wc * 32 + 4 * fq; const float* gmb = gm + (size_t)(u.pm >> 4) * 6144;
        f32x4 gv[2][2];
#pragma unroll
        for (int bj = 0; bj < 2; ++bj)
#pragma unroll
            for (int n = 0; n < 2; ++n) gv[bj][n] = *(const f32x4*)(gmb + col0 + bj * HALF + n * 16);
#pragma unroll
        for (int ai = 0; ai < 2; ++ai)
#pragma unroll
            for (int m = 0; m < 4; ++m) { const size_t off = (size_t)(u.pm * BM + ai * HALF + wr * 64 + m * 16 + fr) * 1024 + col0;
#pragma unroll
                for (int bj = 0; bj < 2; ++bj)
#pragma unroll
                    for (int n = 0; n < 2; ++n) { const f32x4 xs = *(const f32x4*)(x1 + off + bj * HALF + n * 16); *(f32x4*)(out + off + bj * HALF + n * 16) = xs + gv[bj][n] * acc[ai][bj][m][n]; }
                asm volatile("" ::: "memory"); }
    }
};
template <class Epi, class Sched, bool ALIGN_EPI = false, bool SP2 = false>
__device__ __forceinline__ void gemm_phase(PG8_LAS unsigned char* lds, const Gemm g, const Sched& S, const Epi& E) {
    const int tid = threadIdx.x, wid = __builtin_amdgcn_readfirstlane(tid >> 6), lane = tid & 63, wr = wid >> 2, wc = wid & 3, fr = lane & 15, fq = lane >> 4;
    const int K = g.K, nt = K / BK;
    unsigned voffA[2], voffB[2];
#pragma unroll
    for (int i = 0; i < 2; ++i) { int R, C; stage_rc(tid * 16 + i * 8192, R, C); const int Rb = Epi::PERM ? ((R & ~31) + perm32(R & 31)) : R;
        voffA[i] = (unsigned)(R * K + C) * 2u; voffB[i] = (unsigned)(Rb * K + C) * 2u; }
    const size_t kstep = (size_t)(BK * 2);
    const size_t hstep = (size_t)HALF * K * 2;
    const size_t tstep = 2 * hstep;
    const unsigned ldsw = (unsigned)wid * 1024u;
    const int aoff = lds_byte(wr * 64 + fr, fq * 8), boff = lds_byte(wc * 32 + fr, fq * 8);
#define PG8_SA(b, h) (((b) * 2 + (h)) * HTB)
#define PG8_SB(b, h) ((4 + (b) * 2 + (h)) * HTB)
#define PG8_STAGE(bufoff, gbase, voff) do { _Pragma("unroll") for (int _i = 0; _i < 2; ++_i) \
        __builtin_amdgcn_global_load_lds((const unsigned*)((const char*)(gbase) + (voff)[_i]), (PG8_LAS unsigned*)(lds + (bufoff) + ldsw + _i * 8192), 16, 0, 0); } while (0)
#define PG8_LDA(dst, b, h) do { _Pragma("unroll") for (int m = 0; m < 4; ++m) _Pragma("unroll") for (int k = 0; k < 2; ++k) dst[m][k] = *(const PG8_LAS bf16x8*)(lds + PG8_SA(b, h) + aoff + m * 2048 + k * 1024); } while (0)
#define PG8_LDB(dst, b, h) do { _Pragma("unroll") for (int n = 0; n < 2; ++n) _Pragma("unroll") for (int k = 0; k < 2; ++k) dst[n][k] = *(const PG8_LAS bf16x8*)(lds + PG8_SB(b, h) + boff + n * 2048 + k * 1024); } while (0)
#define PG8_MMA(ai, bj, At, Bt) do { __builtin_amdgcn_s_setprio(1); _Pragma("unroll") for (int m = 0; m < 4; ++m) _Pragma("unroll") for (int n = 0; n < 2; ++n) _Pragma("unroll") for (int k = 0; k < 2; ++k) \
        acc[ai][bj][m][n] = __builtin_amdgcn_mfma_f32_16x16x32_bf16(Bt[n][k], At[m][k], acc[ai][bj][m][n], 0, 0, 0); __builtin_amdgcn_s_setprio(0); } while (0)
#define PG8_WAIT_V(n) asm volatile("s_waitcnt vmcnt(" #n ")" ::: "memory")
#define PG8_WAIT_L(n) asm volatile("s_waitcnt lgkmcnt(" #n ")" ::: "memory")
#define PG8_BAR __builtin_amdgcn_s_barrier()
#define PG8_SCHED __builtin_amdgcn_sched_barrier(0)
    Unit cur, nxt; int ui = 0;
    if (!S.next(0, cur)) return;
    f32x4 acc[2][2][4][2];
#pragma unroll
    for (int a = 0; a < 2; ++a)
#pragma unroll
        for (int b = 0; b < 2; ++b)
#pragma unroll
            for (int m = 0; m < 4; ++m)
#pragma unroll
                for (int n = 0; n < 2; ++n) acc[a][b][m][n] = (f32x4){0.f, 0.f, 0.f, 0.f};
    bf16x8 At[4][2], B0[2][2], B1[2][2];
    const char* cA = (const char*)g.A + (size_t)cur.pm * tstep; const char* cB = (const char*)g.Bt + (size_t)cur.pn * tstep;
    S.a_ready(cur);
    if constexpr (SP2) {
        PG8_STAGE(PG8_SB(0, 0), cB, voffB); PG8_STAGE(PG8_SB(0, 1), cB + hstep, voffB); PG8_STAGE(PG8_SA(0, 0), cA, voffA); PG8_STAGE(PG8_SA(0, 1), cA + hstep, voffA);
        if (wr == 1) PG8_BAR;
        PG8_WAIT_V(2); PG8_BAR;
        PG8_STAGE(PG8_SB(1, 0), cB + kstep, voffB); PG8_STAGE(PG8_SA(1, 0), cA + kstep, voffA); PG8_STAGE(PG8_SB(1, 1), cB + hstep + kstep, voffB);
        PG8_WAIT_V(6); PG8_BAR;
    } else {
        PG8_STAGE(PG8_SB(0, 0), cB, voffB); PG8_STAGE(PG8_SA(0, 0), cA, voffA); PG8_STAGE(PG8_SB(0, 1), cB + hstep, voffB); PG8_STAGE(PG8_SA(0, 1), cA + hstep, voffA);
        if (wr == 1) PG8_BAR;
        PG8_WAIT_V(4); PG8_BAR;
        PG8_STAGE(PG8_SB(1, 0), cB + kstep, voffB); PG8_STAGE(PG8_SA(1, 0), cA + kstep, voffA); PG8_STAGE(PG8_SB(1, 1), cB + hstep + kstep, voffB);
        PG8_WAIT_V(6); PG8_BAR;
    }
    for (;;) {
        const bool has_next = S.next(ui + 1, nxt);
        const char* nA = has_next ? (const char*)g.A + (size_t)nxt.pm * tstep : cA; const char* nB = has_next ? (const char*)g.Bt + (size_t)nxt.pn * tstep : cB;
        for (int t = 0; t < nt; t += 2) {
            if constexpr (Epi::HAS_MID) { if (t == (nt >> 1)) E.mid(acc, wr, fr); }
            const bool last = (t == nt - 2);
            const char* a1 = cA + (size_t)(t + 1) * kstep;
            const char* a2 = last ? nA : cA + (size_t)(t + 2) * kstep; const char* b2 = last ? nB : cB + (size_t)(t + 2) * kstep;
            const char* a3 = a2 + kstep; const char* b3 = b2 + kstep;
            if (last && has_next) S.a_ready(nxt);
            if constexpr (SP2) {
            PG8_LDB(B0, 0, 0); PG8_LDB(B1, 0, 1); PG8_SCHED; PG8_LDA(At, 0, 0); PG8_STAGE(PG8_SA(1, 1), a1 + hstep, voffA);
            PG8_WAIT_V(8); PG8_WAIT_L(0); PG8_BAR; PG8_MMA(0, 0, At, B0); PG8_MMA(0, 1, At, B1); PG8_BAR; PG8_SCHED;
            PG8_LDA(At, 0, 1); PG8_STAGE(PG8_SB(0, 0), b2, voffB); PG8_STAGE(PG8_SB(0, 1), b2 + hstep, voffB); PG8_STAGE(PG8_SA(0, 0), a2, voffA);
            PG8_WAIT_V(8); PG8_WAIT_L(0); PG8_BAR; PG8_MMA(1, 0, At, B0); PG8_MMA(1, 1, At, B1); PG8_BAR; PG8_SCHED;
            PG8_LDB(B0, 1, 0); PG8_LDB(B1, 1, 1); PG8_SCHED; PG8_LDA(At, 1, 0); PG8_STAGE(PG8_SA(0, 1), a2 + hstep, voffA);
            PG8_WAIT_V(8); PG8_WAIT_L(0); PG8_BAR; PG8_MMA(0, 0, At, B0); PG8_MMA(0, 1, At, B1); PG8_BAR; PG8_SCHED;
            PG8_LDA(At, 1, 1); PG8_STAGE(PG8_SB(1, 0), b3, voffB); PG8_STAGE(PG8_SB(1, 1), b3 + hstep, voffB); PG8_STAGE(PG8_SA(1, 0), a3, voffA);
            PG8_WAIT_V(8); PG8_WAIT_L(0); PG8_BAR; PG8_MMA(1, 0, At, B0); PG8_MMA(1, 1, At, B1); PG8_BAR; PG8_SCHED;
            } else {
            PG8_LDB(B0, 0, 0); PG8_SCHED; PG8_LDA(At, 0, 0); PG8_STAGE(PG8_SA(1, 1), a1 + hstep, voffA);
            PG8_WAIT_L(8); PG8_BAR; PG8_WAIT_L(0); PG8_MMA(0, 0, At, B0); PG8_BAR; PG8_SCHED;
            PG8_LDB(B1, 0, 1); PG8_STAGE(PG8_SB(0, 0), b2, voffB);
            PG8_BAR; PG8_WAIT_L(0); PG8_MMA(0, 1, At, B1); PG8_BAR;
            PG8_LDA(At, 0, 1); PG8_STAGE(PG8_SA(0, 0), a2, voffA);
            PG8_BAR; PG8_WAIT_L(0); PG8_MMA(1, 0, At, B0); PG8_BAR; PG8_SCHED;
            PG8_STAGE(PG8_SB(0, 1), b2 + hstep, voffB);
            PG8_WAIT_V(6); PG8_BAR; PG8_MMA(1, 1, At, B1); PG8_BAR;
            PG8_LDB(B0, 1, 0); PG8_SCHED; PG8_LDA(At, 1, 0); PG8_STAGE(PG8_SA(0, 1), a2 + hstep, voffA);
            PG8_WAIT_L(8); PG8_BAR; PG8_WAIT_L(0); PG8_MMA(0, 0, At, B0); PG8_BAR; PG8_SCHED;
            PG8_LDB(B1, 1, 1); PG8_STAGE(PG8_SB(1, 0), b3, voffB);
            PG8_BAR; PG8_WAIT_L(0); PG8_MMA(0, 1, At, B1); PG8_BAR;
            PG8_LDA(At, 1, 1); PG8_STAGE(PG8_SA(1, 0), a3, voffA);
            PG8_BAR; PG8_WAIT_L(0); PG8_MMA(1, 0, At, B0); PG8_BAR; PG8_SCHED;
            PG8_STAGE(PG8_SB(1, 1), b3 + hstep, voffB);
            PG8_WAIT_V(6); PG8_BAR; PG8_MMA(1, 1, At, B1); PG8_BAR;
            }
        }
        if constexpr (ALIGN_EPI) { if (wr == 0) PG8_BAR; }
        if constexpr (!Epi::AFTER_DRAIN) { E(acc, cur, wr, wc, fr, fq); S.done(cur); }
        if (!has_next) break;
#pragma unroll
        for (int a = 0; a < 2; ++a)
#pragma unroll
            for (int b = 0; b < 2; ++b)
#pragma unroll
                for (int m = 0; m < 4; ++m)
#pragma unroll
                    for (int n = 0; n < 2; ++n) acc[a][b][m][n] = (f32x4){0.f, 0.f, 0.f, 0.f};
        cur = nxt; cA = nA; cB = nB; ++ui;
        if constexpr (ALIGN_EPI) { if (wr == 1) PG8_BAR; }
    }
    PG8_WAIT_V(0);
    if constexpr (!ALIGN_EPI) { if (wr == 0) PG8_BAR; }
    PG8_BAR;
    if constexpr (Epi::AFTER_DRAIN) { E.fused(acc, cur, wr, wc, fr, fq, lds, wid, lane); S.done(cur); }
#undef PG8_SA
#undef PG8_SB
#undef PG8_STAGE
#undef PG8_LDA
#undef PG8_LDB
#undef PG8_MMA
#undef PG8_WAIT_V
#undef PG8_WAIT_L
#undef PG8_BAR
#undef PG8_SCHED
}
}

namespace att {
#define ATT_LAS __attribute__((address_space(3)))
typedef unsigned short bf16_t;
typedef short bf16x8 __attribute__((ext_vector_type(8)));
typedef short s16x4 __attribute__((ext_vector_type(4)));
typedef float f32x16 __attribute__((ext_vector_type(16)));
typedef float f32x4 __attribute__((ext_vector_type(4)));
typedef unsigned u32x4 __attribute__((ext_vector_type(4)));
constexpr int SEQ = 4096, NQKV = 3072;
constexpr int ROWB = 144;
constexpr int TILEB = 64 * ROWB;
constexpr int L_K = 0, L_V = 2 * TILEB, L_CK = 4 * TILEB, L_KMH = L_CK + 512, L_KML = L_KMH + 32 * ROWB, L_WS = L_KML + 32 * ROWB, L_END = L_WS + 8 * 256;
constexpr float NEG = -1.0e30f;
__device__ __forceinline__ unsigned cvtpk(float lo, float hi) { unsigned r; asm volatile("v_cvt_pk_bf16_f32 %0, %1, %2" : "=v"(r) : "v"(lo), "v"(hi)); return r; }
__device__ __forceinline__ s16x4 vtr(const ATT_LAS unsigned char* p) { return __builtin_bit_cast(s16x4, __builtin_amdgcn_ds_read_tr16_b64_v4i16((ATT_LAS s16x4*)p)); }
__device__ __forceinline__ unsigned f2bf(float f) { unsigned u = __builtin_bit_cast(unsigned, f); return (u + 0x7fffu + ((u >> 16) & 1u)) >> 16; }

template <bool FOX>
__device__ __forceinline__ void attn_unit(int b, int h, int qb, const bf16_t* __restrict__ QKV, const float* __restrict__ cl, const float* __restrict__ kmean,
                                          bf16_t* __restrict__ O, float* __restrict__ ssq, ATT_LAS unsigned char* lds) {
    const int tid = threadIdx.x, lane = tid & 63, r32 = lane & 31, hi = lane >> 5;
    const int wid = __builtin_amdgcn_readfirstlane(tid >> 6);
    const int qcol = FOX ? 1536 + h * 64 : h * 64, kcol = qcol + 512, vcol = qcol + 1024, ocol = FOX ? 512 + h * 64 : h * 64;
    const size_t rowbase = (size_t)b * SEQ; const int q0 = qb * 256;
    const int qpos = q0 + wid * 32 + r32;
    bf16x8 qr[4];
    { const bf16_t* qp = QKV + (rowbase + qpos) * NQKV + qcol + hi * 8;
#pragma unroll
      for (int d0 = 0; d0 < 4; ++d0) qr[d0] = *(const bf16x8*)(qp + d0 * 16); }
    const int lrow = tid >> 3, lch = tid & 7;
    const bf16_t* ksrc = QKV + (rowbase + lrow) * NQKV + kcol + lch * 8;
    const bf16_t* vsrc = QKV + (rowbase + lrow) * NQKV + vcol + lch * 8;
    const int ldst = lrow * ROWB + lch * 16;
    const float* clh = cl + (size_t)(b * 8 + h) * SEQ;
    float cq = 0.f; if (FOX) cq = clh[qpos];
    unsigned sel = 0xffffffffu;
    ATT_LAS float* wsf = (ATT_LAS float*)(lds + L_WS) + wid * 64;
    if (!FOX) {
        { const float* km = kmean + (size_t)(b * 8 + h) * 1024;
          const int i0 = tid * 2, n = i0 >> 6, d = i0 & 63;
          const float v0 = km[i0], v1 = km[i0 + 1];
          const unsigned h0 = f2bf(v0), h1 = f2bf(v1);
          const float r0 = v0 - __uint_as_float(h0 << 16), r1 = v1 - __uint_as_float(h1 << 16);
          *(ATT_LAS unsigned*)(lds + L_KMH + n * ROWB + d * 2) = h0 | (h1 << 16);
          *(ATT_LAS unsigned*)(lds + L_KML + n * ROWB + d * 2) = f2bf(r0) | (f2bf(r1) << 16);
          *(ATT_LAS unsigned*)(lds + L_KMH + (16 + n) * ROWB + d * 2) = 0u;
          *(ATT_LAS unsigned*)(lds + L_KML + (16 + n) * ROWB + d * 2) = 0u; }
        __syncthreads();
        f32x16 g = {};
#pragma unroll
        for (int d0 = 0; d0 < 4; ++d0) {
            const bf16x8 kh = *(const ATT_LAS bf16x8*)(lds + L_KMH + r32 * ROWB + (d0 * 16 + hi * 8) * 2);
            const bf16x8 kl = *(const ATT_LAS bf16x8*)(lds + L_KML + r32 * ROWB + (d0 * 16 + hi * 8) * 2);
            g = __builtin_amdgcn_mfma_f32_32x32x16_bf16(kh, qr[d0], g, 0, 0, 0);
            g = __builtin_amdgcn_mfma_f32_32x32x16_bf16(kl, qr[d0], g, 0, 0, 0);
        }
        float G[16];
#pragma unroll
        for (int n = 0; n < 16; ++n) { const int r = (n & 3) + 4 * (n >> 3); const float mine = g[r], oth = __shfl_xor(g[r], 32); G[n] = (((n >> 2) & 1) == hi) ? mine : oth; }
        sel = 0u;
#pragma unroll
        for (int pass = 0; pass < 3; ++pass) {
            float best = -INFINITY; int bi = -1;
#pragma unroll
            for (int n = 0; n < 16; ++n) { const bool ok = (n < qb) && (((sel >> n) & 1u) == 0u) && (G[n] > best); if (ok) { best = G[n]; bi = n; } }
            if (bi >= 0) sel |= (1u << bi);
        }
    }
    const int NT = 4 * (qb + 1);
    u32x4 kreg = *(const u32x4*)ksrc, vreg = *(const u32x4*)vsrc; float ckr = 0.f;
    if (FOX && tid < 64) ckr = clh[tid];
    *(ATT_LAS u32x4*)(lds + L_K + ldst) = kreg; *(ATT_LAS u32x4*)(lds + L_V + ldst) = vreg;
    if (FOX && tid < 64) *(ATT_LAS float*)(lds + L_CK + tid * 4) = ckr;
    __syncthreads();
    float m_run = NEG, l_run = 0.f; f32x16 o0 = {}, o1 = {};
    const int vrow = 4 * hi + ((lane & 15) >> 2), vcb = (16 * ((lane >> 4) & 1) + 4 * (lane & 3)) * 2;
    for (int t = 0; t < NT; ++t) {
        const int buf = t & 1;
        if (t + 1 < NT) {
            kreg = *(const u32x4*)(ksrc + (size_t)(t + 1) * 64 * NQKV); vreg = *(const u32x4*)(vsrc + (size_t)(t + 1) * 64 * NQKV);
            if (FOX && tid < 64) ckr = clh[(t + 1) * 64 + tid];
        }
        const int blk = t >> 2, jb = t & 3; const bool diag = (blk == qb);
        bool act = !(diag && (64 * jb > 32 * wid + 31));
        bool allowed = true;
        if (!FOX && !diag) { allowed = ((sel >> blk) & 1u) != 0u; act = act && (__any(allowed ? 1 : 0) != 0); }
        if (act) {
            const ATT_LAS unsigned char* Kb = lds + L_K + buf * TILEB; const ATT_LAS unsigned char* Vb = lds + L_V + buf * TILEB;
            f32x16 p0, p1;
            if (FOX) {
                const ATT_LAS float* ck = (const ATT_LAS float*)(lds + L_CK + buf * 256);
#pragma unroll
                for (int gq = 0; gq < 4; ++gq) { const f32x4 c0 = *(const ATT_LAS f32x4*)(ck + 8 * gq + 4 * hi), c1 = *(const ATT_LAS f32x4*)(ck + 32 + 8 * gq + 4 * hi);
#pragma unroll
                    for (int e = 0; e < 4; ++e) { p0[4 * gq + e] = cq - c0[e]; p1[4 * gq + e] = cq - c1[e]; } }
            } else { p0 = (f32x16){}; p1 = (f32x16){}; }
#pragma unroll
            for (int d0 = 0; d0 < 4; ++d0) {
                const bf16x8 k0 = *(const ATT_LAS bf16x8*)(Kb + r32 * ROWB + (d0 * 16 + hi * 8) * 2);
                const bf16x8 k1 = *(const ATT_LAS bf16x8*)(Kb + (32 + r32) * ROWB + (d0 * 16 + hi * 8) * 2);
                p0 = __builtin_amdgcn_mfma_f32_32x32x16_bf16(k0, qr[d0], p0, 0, 0, 0);
                p1 = __builtin_amdgcn_mfma_f32_32x32x16_bf16(k1, qr[d0], p1, 0, 0, 0);
            }
            if (diag) {
                const int kv0 = jb * 64 + 4 * hi, qrel = wid * 32 + r32;
#pragma unroll
                for (int r = 0; r < 16; ++r) { const int kv = kv0 + (r & 3) + 8 * (r >> 2); if (kv > qrel) p0[r] = NEG; if (kv + 32 > qrel) p1[r] = NEG; }
            } else if (!FOX) {
                if (!allowed) {
#pragma unroll
                    for (int r = 0; r < 16; ++r) { p0[r] = NEG; p1[r] = NEG; } }
            }
            float mx = fmaxf(p0[0], p1[0]);
#pragma unroll
            for (int r = 1; r < 16; ++r) mx = fmaxf(mx, fmaxf(p0[r], p1[r]));
            mx = fmaxf(mx, __shfl_xor(mx, 32));
            const float m_new = fmaxf(m_run, mx);
            const float alpha = __builtin_amdgcn_exp2f(m_run - m_new); m_run = m_new;
            float ls = 0.f;
#pragma unroll
            for (int r = 0; r < 16; ++r) { p0[r] = __builtin_amdgcn_exp2f(p0[r] - m_new); p1[r] = __builtin_amdgcn_exp2f(p1[r] - m_new); ls += p0[r] + p1[r]; }
            l_run = l_run * alpha + ls;
            if (__any(alpha != 1.0f ? 1 : 0)) {
                if (hi == 0) wsf[r32] = alpha;
                asm volatile("s_waitcnt lgkmcnt(0)" ::: "memory");
#pragma unroll
                for (int gq = 0; gq < 4; ++gq) { const f32x4 a = *(const ATT_LAS f32x4*)(wsf + 8 * gq + 4 * hi);
#pragma unroll
                    for (int e = 0; e < 4; ++e) { o0[4 * gq + e] *= a[e]; o1[4 * gq + e] *= a[e]; } }
            }
#pragma unroll
            for (int c = 0; c < 2; ++c)
#pragma unroll
                for (int uu = 0; uu < 2; ++uu) {
                    u32x4 pw;
                    if (c == 0) { pw.x = cvtpk(p0[8 * uu + 0], p0[8 * uu + 1]); pw.y = cvtpk(p0[8 * uu + 2], p0[8 * uu + 3]); pw.z = cvtpk(p0[8 * uu + 4], p0[8 * uu + 5]); pw.w = cvtpk(p0[8 * uu + 6], p0[8 * uu + 7]); }
                    else        { pw.x = cvtpk(p1[8 * uu + 0], p1[8 * uu + 1]); pw.y = cvtpk(p1[8 * uu + 2], p1[8 * uu + 3]); pw.z = cvtpk(p1[8 * uu + 4], p1[8 * uu + 5]); pw.w = cvtpk(p1[8 * uu + 6], p1[8 * uu + 7]); }
                    const bf16x8 pa = __builtin_bit_cast(bf16x8, pw);
                    const ATT_LAS unsigned char* vp = Vb + (32 * c + 16 * uu + vrow) * ROWB + vcb;
                    const s16x4 a0 = vtr(vp), a1 = vtr(vp + 8 * ROWB), b0 = vtr(vp + 64), b1 = vtr(vp + 8 * ROWB + 64);
                    const bf16x8 vf0 = {a0[0], a0[1], a0[2], a0[3], a1[0], a1[1], a1[2], a1[3]};
                    const bf16x8 vf1 = {b0[0], b0[1], b0[2], b0[3], b1[0], b1[1], b1[2], b1[3]};
                    o0 = __builtin_amdgcn_mfma_f32_32x32x16_bf16(pa, vf0, o0, 0, 0, 0);
                    o1 = __builtin_amdgcn_mfma_f32_32x32x16_bf16(pa, vf1, o1, 0, 0, 0);
                }
        }
        if (t + 1 < NT) {
            *(ATT_LAS u32x4*)(lds + L_K + (buf ^ 1) * TILEB + ldst) = kreg; *(ATT_LAS u32x4*)(lds + L_V + (buf ^ 1) * TILEB + ldst) = vreg;
            if (FOX && tid < 64) *(ATT_LAS float*)(lds + L_CK + (buf ^ 1) * 256 + tid * 4) = ckr;
        }
        __syncthreads();
    }
    l_run += __shfl_xor(l_run, 32);
    if (hi == 0) wsf[r32] = 1.0f / l_run;
    asm volatile("s_waitcnt lgkmcnt(0)" ::: "memory");
    bf16_t* Ow = O + (rowbase + q0 + wid * 32) * 1024 + ocol + r32;
    float* sq = ssq + (FOX ? 16384 : 0) + rowbase + q0 + wid * 32;
#pragma unroll
    for (int gq = 0; gq < 4; ++gq) { const f32x4 a = *(const ATT_LAS f32x4*)(wsf + 8 * gq + 4 * hi);
#pragma unroll
        for (int e = 0; e < 4; ++e) { const int r = 4 * gq + e, row = 8 * gq + 4 * hi + e;
            const unsigned w0 = f2bf(o0[r] * a[e]), w1 = f2bf(o1[r] * a[e]);
            Ow[(size_t)row * 1024] = (bf16_t)w0; Ow[(size_t)row * 1024 + 32] = (bf16_t)w1;
            const float f0 = __uint_as_float(w0 << 16), f1 = __uint_as_float(w1 << 16);
            float s = f0 * f0 + f1 * f1;
            s += __shfl_xor(s, 1); s += __shfl_xor(s, 2); s += __shfl_xor(s, 4); s += __shfl_xor(s, 8); s += __shfl_xor(s, 16);
            if (r32 == 0) atomicAdd(sq + row, s); } }
    __syncthreads();
}
}

namespace cg = cooperative_groups;
#define LAS __attribute__((address_space(3)))
typedef unsigned short bf16;
typedef unsigned v4u __attribute__((ext_vector_type(4)));
typedef float f32x4 __attribute__((ext_vector_type(4)));
constexpr int NWAVES = 8;
constexpr int BATCH = 4, SEQ = 4096, D = 1024, M = BATCH * SEQ, NQKV = 3072, INW = 3080, FF = 4096, NHG = 8;
constexpr float EPS = 1e-6f, LOG2E = 1.4426950408889634f;
constexpr size_t MiB = 1u << 20;
constexpr size_t WS_CTL = 0, CTL_ZERO_BYTES = 1 * MiB;
constexpr size_t OFF_MOD = 64 * 1024;
constexpr size_t OFF_KMEAN = 256 * 1024;
constexpr size_t OFF_SSQO = 512 * 1024;
constexpr size_t OFF_SSQ2 = 768 * 1024;
constexpr size_t WS_GAINS = 3 * MiB;
constexpr size_t WS_ROPE = 1 * MiB;
constexpr size_t WS_LOGF = 2 * MiB;
constexpr size_t WS_CUM = WS_LOGF + 512 * 1024;
constexpr size_t WS_WIN = 4 * MiB, WS_WOUT = 10 * MiB, WS_W1 = 12 * MiB, WS_W2 = 20 * MiB;
constexpr size_t WS_XN = 32 * MiB;
constexpr size_t WS_QKV = 64 * MiB;
constexpr size_t WS_O = 160 * MiB;
constexpr size_t WS_X1 = 192 * MiB;
constexpr size_t WS_H = 64 * MiB;
constexpr size_t WS_END = 256 * MiB;
constexpr int RING_BYTES = 131072, XOFF = RING_BYTES, LDS_BYTES = RING_BYTES + 24576;

__device__ __forceinline__ unsigned f2bf(float f) { unsigned u = __builtin_bit_cast(unsigned, f); return (u + 0x7fffu + ((u >> 16) & 1u)) >> 16; }
__device__ __forceinline__ unsigned pk2(float lo, float hi) { return f2bf(lo) | (f2bf(hi) << 16); }
__device__ __forceinline__ float wave_sum(float v) {
#pragma unroll
    for (int o = 1; o < 64; o <<= 1) v += __shfl_xor(v, o);
    return v;
}
__device__ __forceinline__ void transpose_item(const float* W, int ldw, int nblk, int K, bf16* WT, LAS float* scr, int item, int lane, const float* g0, const float* g1) {
    const int kb = item / nblk, nb = item % nblk, k0 = 64 * kb, n0 = 32 * nb;
#pragma unroll 8
    for (int i = 0; i < 32; ++i) { const int kk = 2 * i + (lane >> 5); float v = W[(size_t)(k0 + kk) * ldw + n0 + (lane & 31)];
        if (g0) { const int k = k0 + kk; v *= (k < 512) ? g0[k] : g1[k - 512]; }
        scr[kk * 33 + (lane & 31)] = v; }
    asm volatile("s_waitcnt lgkmcnt(0)" ::: "memory");
    const int c = lane & 7;
#pragma unroll
    for (int j = 0; j < 4; ++j) { const int n = (lane >> 3) + 8 * j; const LAS float* s = scr + (8 * c) * 33 + n;
        v4u o; o.x = pk2(s[0 * 33], s[1 * 33]); o.y = pk2(s[2 * 33], s[3 * 33]); o.z = pk2(s[4 * 33], s[5 * 33]); o.w = pk2(s[6 * 33], s[7 * 33]);
        *(v4u*)(WT + (size_t)(n0 + n) * K + k0 + 8 * c) = o; }
    asm volatile("s_waitcnt lgkmcnt(0)" ::: "memory");
}
__device__ __forceinline__ void cossin_acc(float ang, float& c, float& s) {
    double r = (double)ang; const double n = __builtin_rint(r * 0.15915494309189535); r = __builtin_fma(-n, 6.283185307179586, r);
    const double r2 = r * r;
    double ps = -1.0 / 51090942171709440000.0;
    ps = ps * r2 + 1.0 / 121645100408832000.0;
    ps = ps * r2 - 1.0 / 355687428096000.0;
    ps = ps * r2 + 1.0 / 1307674368000.0;
    ps = ps * r2 - 1.0 / 6227020800.0;
    ps = ps * r2 + 1.0 / 39916800.0;
    ps = ps * r2 - 1.0 / 362880.0;
    ps = ps * r2 + 1.0 / 5040.0;
    ps = ps * r2 - 1.0 / 120.0;
    ps = ps * r2 + 1.0 / 6.0;
    s = (float)(r - r * r2 * ps);
    double pc = 1.0 / 2432902008176640000.0;
    pc = pc * r2 - 1.0 / 6402373705728000.0;
    pc = pc * r2 + 1.0 / 20922789888000.0;
    pc = pc * r2 - 1.0 / 87178291200.0;
    pc = pc * r2 + 1.0 / 479001600.0;
    pc = pc * r2 - 1.0 / 3628800.0;
    pc = pc * r2 + 1.0 / 40320.0;
    pc = pc * r2 - 1.0 / 720.0;
    pc = pc * r2 + 1.0 / 24.0;
    pc = pc * r2 - 0.5;
    c = (float)(1.0 + r2 * pc);
}

struct Args { const float* in[15]; float* out; unsigned char* ws; float invf[8]; };

__global__ void __launch_bounds__(NWAVES * 64, 2) fwd_mega(Args args) {
    extern __shared__ __attribute__((aligned(16))) unsigned char lds_raw[];
    LAS unsigned char* lds = (LAS unsigned char*)lds_raw;
    cg::grid_group grid = cg::this_grid();
    const int tid = threadIdx.x, lane = tid & 63, wave = __builtin_amdgcn_readfirstlane(tid >> 6);
    const int G = gridDim.x, bx = blockIdx.x;
    const int vcu = (G % 8 == 0) ? (bx % 8) * (G / 8) + bx / 8 : bx;
    const int gw = vcu * NWAVES + wave, NGW = G * NWAVES;
    unsigned char* ws = args.ws;
    const float* x = args.in[0]; const float* cin = args.in[1]; const float* w_ada = args.in[2]; const float* b_ada = args.in[3]; const float* w_in = args.in[4];
    const float* b_forget = args.in[5]; const float* g_qn_moba = args.in[6]; const float* g_kn_moba = args.in[7]; const float* g_qn_fox = args.in[8]; const float* g_kn_fox = args.in[9];
    const float* g_out_moba = args.in[10]; const float* g_out_fox = args.in[11]; const float* w_out = args.in[12]; const float* w_ff1 = args.in[13]; const float* w_ff2 = args.in[14];
    float* mod = (float*)(ws + OFF_MOD); float* kmean = (float*)(ws + OFF_KMEAN); float* ssqo = (float*)(ws + OFF_SSQO); float* ssq2 = (float*)(ws + OFF_SSQ2);
    float* gains4 = (float*)(ws + WS_GAINS); float* rope = (float*)(ws + WS_ROPE); float* logf_ = (float*)(ws + WS_LOGF); float* cum = (float*)(ws + WS_CUM);
    bf16* Win_t = (bf16*)(ws + WS_WIN); bf16* Wout_t = (bf16*)(ws + WS_WOUT); bf16* W1_t = (bf16*)(ws + WS_W1); bf16* W2_t = (bf16*)(ws + WS_W2);
    bf16* XN = (bf16*)(ws + WS_XN); bf16* QKV = (bf16*)(ws + WS_QKV); bf16* OB = (bf16*)(ws + WS_O); float* X1 = (float*)(ws + WS_X1); bf16* HB = (bf16*)(ws + WS_H);
#define GRID_BAR() grid.sync()

#ifndef NO_P0A
    {
        LAS float* sc = (LAS float*)(lds + XOFF);
        for (int i = tid; i < 4096; i += NWAVES * 64) { const float v = cin[i]; sc[i] = v / (1.f + __expf(-v)); }
        __syncthreads();
        for (int it = gw; it < 1536; it += NGW) {
            const int cb = it % 96, kc = it / 96, col = 64 * cb + lane;
            float a0 = 0.f, a1 = 0.f, a2 = 0.f, a3 = 0.f;
#pragma unroll 8
            for (int k = 64 * kc; k < 64 * kc + 64; ++k) { const float w = w_ada[(size_t)k * 6144 + col]; a0 += sc[k] * w; a1 += sc[1024 + k] * w; a2 += sc[2048 + k] * w; a3 += sc[3072 + k] * w; }
            if (kc == 0) { const float bb = b_ada[col]; a0 += bb; a1 += bb; a2 += bb; a3 += bb; }
            atomicAdd(mod + col, a0); atomicAdd(mod + 6144 + col, a1); atomicAdd(mod + 2 * 6144 + col, a2); atomicAdd(mod + 3 * 6144 + col, a3);
        }
        if (bx == 0 && tid < 256) { const float* gsrc = (tid < 64) ? g_qn_moba : (tid < 128) ? g_kn_moba : (tid < 192) ? g_qn_fox : g_kn_fox; gains4[tid] = gsrc[tid & 63]; }
        LAS float* scr = (LAS float*)(lds + wave * 16384);
        constexpr int I_IN = 16 * 96, I_O = 16 * 32, I_1 = 16 * 128, I_2 = 64 * 32, NITEMS = I_IN + I_O + I_1 + I_2;
        for (int it = gw; it < NITEMS; it += NGW) {
            int r = it;
            if (r < I_IN) { transpose_item(w_in, INW, 96, D, Win_t, scr, r, lane, nullptr, nullptr); continue; } r -= I_IN;
            if (r < I_O) { transpose_item(w_out, D, 32, D, Wout_t, scr, r, lane, g_out_moba, g_out_fox); continue; } r -= I_O;
            if (r < I_1) { transpose_item(w_ff1, FF, 128, D, W1_t, scr, r, lane, nullptr, nullptr); continue; } r -= I_1;
            transpose_item(w_ff2, D, 32, FF, W2_t, scr, r, lane, nullptr, nullptr);
        }
        for (int i = (vcu * NWAVES * 64) + tid; i < 4096 * 8; i += G * NWAVES * 64) { const int t = i >> 3, j = i & 7; float c, s; cossin_acc((float)t * args.invf[j], c, s); rope[t * 16 + j] = c; rope[t * 16 + 8 + j] = s; }
    }
#endif
    GRID_BAR();

#ifndef NO_P0B
    {
        LAS float* wf = (LAS float*)lds;
        for (int i = tid; i < 8192; i += NWAVES * 64) { const int k = i >> 3, hh = i & 7; wf[hh * 1024 + k] = w_in[(size_t)k * INW + 3072 + hh]; }
        __syncthreads();
        for (int m = gw; m < M; m += NGW) {
            const int b = m >> 12, t = m & 4095; const float* mb = mod + (size_t)b * 6144;
            const f32x4* xr = (const f32x4*)(x + (size_t)m * D) + lane;
            f32x4 v[4]; float s = 0.f;
#pragma unroll
            for (int j = 0; j < 4; ++j) { v[j] = xr[64 * j]; s += (v[j].x * v[j].x + v[j].y * v[j].y) + (v[j].z * v[j].z + v[j].w * v[j].w); }
            const float rs = 1.0f / sqrtf(wave_sum(s) * (1.f / D) + EPS);
            float fl[8];
#pragma unroll
            for (int hh = 0; hh < 8; ++hh) fl[hh] = 0.f;
            unsigned long long* o8 = (unsigned long long*)(XN + (size_t)m * D) + lane;
#pragma unroll
            for (int j = 0; j < 4; ++j) { const int col = 4 * lane + 256 * j;
                const f32x4 sh = *(const f32x4*)(mb + col), scl = *(const f32x4*)(mb + 1024 + col);
                const f32x4 hv = v[j] * rs * (scl + 1.0f) + sh;
                o8[64 * j] = (unsigned long long)pk2(hv.x, hv.y) | ((unsigned long long)pk2(hv.z, hv.w) << 32);
#pragma unroll
                for (int hh = 0; hh < 8; ++hh) { const f32x4 w = *(const LAS f32x4*)(wf + hh * 1024 + col); fl[hh] += (hv.x * w.x + hv.y * w.y) + (hv.z * w.z + hv.w * w.w); } }
#pragma unroll
            for (int hh = 0; hh < 8; ++hh) fl[hh] = wave_sum(fl[hh]);
            float mine = fl[0];
#pragma unroll
            for (int hh = 1; hh < 8; ++hh) mine = (lane == hh) ? fl[hh] : mine;
            if (lane < 8) { const float z = mine + b_forget[lane]; const float ls = fminf(z, 0.f) - log1pf(__expf(-fabsf(z))); logf_[(size_t)(b * 8 + lane) * SEQ + t] = ls; }
        }
    }
#endif
    GRID_BAR();

#ifndef NO_P1
    {
        if (bx < 32) {
            LAS float* wt = (LAS float*)(lds + XOFF);
            const float* src = logf_ + (size_t)bx * SEQ + tid * 8;
            const f32x4 a = *(const f32x4*)src, b2 = *(const f32x4*)(src + 4);
            float p[8]; p[0] = a.x; p[1] = p[0] + a.y; p[2] = p[1] + a.z; p[3] = p[2] + a.w; p[4] = p[3] + b2.x; p[5] = p[4] + b2.y; p[6] = p[5] + b2.z; p[7] = p[6] + b2.w;
            float incl = p[7];
#pragma unroll
            for (int o = 1; o < 64; o <<= 1) { const float up = __shfl_up(incl, o); if (lane >= o) incl += up; }
            if (lane == 63) wt[wave] = incl;
            __syncthreads();
            float base = incl - p[7];
            for (int w = 0; w < wave; ++w) base += wt[w];
            float* dst = cum + (size_t)bx * SEQ + tid * 8;
            f32x4 o0, o1; o0.x = (base + p[0]) * LOG2E; o0.y = (base + p[1]) * LOG2E; o0.z = (base + p[2]) * LOG2E; o0.w = (base + p[3]) * LOG2E;
            o1.x = (base + p[4]) * LOG2E; o1.y = (base + p[5]) * LOG2E; o1.z = (base + p[6]) * LOG2E; o1.w = (base + p[7]) * LOG2E;
            *(f32x4*)dst = o0; *(f32x4*)(dst + 4) = o1;
            __syncthreads();
        }
        pg8::Gemm g{XN, Win_t, M, NQKV, D}; pg8::StaticOrder S; S.init(M, NQKV, G, bx);
        pg8::EpiQKV E{QKV, gains4, rope, (LAS float*)(lds + XOFF)};
        pg8::gemm_phase<pg8::EpiQKV, pg8::StaticOrder, true, true>(lds, g, S, E);
        { pg8::Unit u;
          for (int i = 0; S.next(i, u); ++i) if ((u.pn >> 1) == 1) {
              const int cch = tid & 31, rg = tid >> 5;
              float s8[8];
#pragma unroll
              for (int e = 0; e < 8; ++e) s8[e] = 0.f;
#pragma unroll 4
              for (int r = 0; r < 16; ++r) { const v4u v = *(const v4u*)(QKV + (size_t)(u.pm * 256 + rg + 16 * r) * NQKV + u.pn * 256 + cch * 8);
                  s8[0] += __uint_as_float(v.x << 16); s8[1] += __uint_as_float(v.x & 0xffff0000u); s8[2] += __uint_as_float(v.y << 16); s8[3] += __uint_as_float(v.y & 0xffff0000u);
                  s8[4] += __uint_as_float(v.z << 16); s8[5] += __uint_as_float(v.z & 0xffff0000u); s8[6] += __uint_as_float(v.w << 16); s8[7] += __uint_as_float(v.w & 0xffff0000u); }
              LAS float* part = (LAS float*)lds;
#pragma unroll
              for (int e = 0; e < 8; ++e) part[rg * 256 + cch * 8 + e] = s8[e];
              __syncthreads();
              if (tid < 256) { float t = 0.f;
#pragma unroll
                  for (int r = 0; r < 16; ++r) t += part[r * 256 + tid];
                  const int head = (u.pn & 1) * 4 + (tid >> 6), b = u.pm >> 4, blk = u.pm & 15;
                  kmean[((size_t)((b * 8 + head) * 16 + blk)) * 64 + (tid & 63)] = t; }
              __syncthreads();
          } }
    }
#endif
    GRID_BAR();

#ifndef NO_P2
    {
        if (G == 256) {
            const int kbh = vcu >> 2, s4 = vcu & 3, kind = kbh >> 5, bh = kbh & 31;
            for (int i = 0; i < 4; ++i) { const int qb = (i == 0) ? 15 - 2 * s4 : (i == 1) ? 14 - 2 * s4 : (i == 2) ? 2 * s4 + 1 : 2 * s4;
                if (kind) att::attn_unit<true>(bh >> 3, bh & 7, qb, QKV, cum, kmean, OB, ssqo, lds); else att::attn_unit<false>(bh >> 3, bh & 7, qb, QKV, cum, kmean, OB, ssqo, lds); }
        } else {
            for (int u = vcu; u < 1024; u += G) { const int qb = 15 - (u & 15), kbh = u >> 4, kind = kbh >> 5, bh = kbh & 31;
                if (kind) att::attn_unit<true>(bh >> 3, bh & 7, qb, QKV, cum, kmean, OB, ssqo, lds); else att::attn_unit<false>(bh >> 3, bh & 7, qb, QKV, cum, kmean, OB, ssqo, lds); }
        }
    }
#endif
    GRID_BAR();

#ifndef NO_P3
    {
        pg8::Gemm g{OB, Wout_t, M, D, D}; pg8::StaticOrder S; S.init(M, D, G, bx);
        LAS float* tab = (LAS float*)(lds + XOFF);
        pg8::Unit u0;
        if (S.next(0, u0)) {
            if (tid < 256) { const int row = u0.pm * 256 + tid; const float rm = 1.0f / sqrtf(ssqo[row] * (1.f / 512.f) + EPS), rf = 1.0f / sqrtf(ssqo[16384 + row] * (1.f / 512.f) + EPS);
                tab[tid] = rm / rf; tab[256 + tid] = rf; }
        }
        __syncthreads();
        pg8::EpiOut E{x, X1, mod + 2048, ssq2, tab};
        pg8::gemm_phase<pg8::EpiOut, pg8::StaticOrder, false, true>(lds, g, S, E);
    }
#endif
    GRID_BAR();

#ifndef NO_P3B
    {
        for (int m = gw; m < M; m += NGW) {
            const int b = m >> 12; const float* mb = mod + (size_t)b * 6144;
            const f32x4* xr = (const f32x4*)(X1 + (size_t)m * D) + lane;
            const float rs = 1.0f / sqrtf(ssq2[m] * (1.f / D) + EPS);
            unsigned long long* o8 = (unsigned long long*)(XN + (size_t)m * D) + lane;
#pragma unroll
            for (int j = 0; j < 4; ++j) { const int col = 4 * lane + 256 * j;
                const f32x4 sh = *(const f32x4*)(mb + 3072 + col), scl = *(const f32x4*)(mb + 4096 + col);
                const f32x4 hv = xr[64 * j] * rs * (scl + 1.0f) + sh;
                o8[64 * j] = (unsigned long long)pk2(hv.x, hv.y) | ((unsigned long long)pk2(hv.z, hv.w) << 32); }
        }
    }
#endif
    GRID_BAR();

#ifndef NO_P4
    {
        pg8::Gemm g{XN, W1_t, M, FF, D}; pg8::StaticOrder S; S.init(M, FF, G, bx);
        pg8::EpiRelu2 E{HB, FF};
        pg8::gemm_phase<pg8::EpiRelu2, pg8::StaticOrder, true, true>(lds, g, S, E);
    }
#endif
    GRID_BAR();

#ifndef NO_P5
    {
        pg8::Gemm g{HB, W2_t, M, D, FF}; pg8::StaticOrder S; S.init(M, D, G, bx);
        pg8::EpiFinal E{X1, args.out, mod + 5120};
        pg8::gemm_phase<pg8::EpiFinal, pg8::StaticOrder, false, true>(lds, g, S, E);
    }
#endif
}

extern "C" void kernel_launch(void* const* d_in, const int* in_sizes, int n_in, void* d_out, int out_size, void* d_ws, size_t ws_size, hipStream_t stream) {
    static int grid = 0;
    if (grid == 0) {
        if (n_in != 15 || out_size != M * D || ws_size < WS_END) { fprintf(stderr, "kernel_launch: unexpected problem (n_in %d out %d ws %zu)\n", n_in, out_size, ws_size); grid = -1; return; }
        int dev = 0, cus = 0, per_cu = 0;
        hipGetDevice(&dev); hipDeviceGetAttribute(&cus, hipDeviceAttributeMultiprocessorCount, dev);
        if (hipFuncSetAttribute((const void*)fwd_mega, hipFuncAttributeMaxDynamicSharedMemorySize, LDS_BYTES) != hipSuccess) { fprintf(stderr, "kernel_launch: hipFuncSetAttribute failed\n"); grid = -1; return; }
        if (hipOccupancyMaxActiveBlocksPerMultiprocessor(&per_cu, (const void*)fwd_mega, NWAVES * 64, LDS_BYTES) != hipSuccess || per_cu < 1) { fprintf(stderr, "kernel_launch: occupancy query says %d\n", per_cu); per_cu = 1; }
        (void)hipGetLastError();
        grid = cus * per_cu;
        fprintf(stderr, "kernel_launch: grid %d (cus %d per_cu %d)\n", grid, cus, per_cu);
    }
    if (grid < 0) return;
    hipMemsetAsync((char*)d_ws + WS_CTL, 0, CTL_ZERO_BYTES, stream);
    Args a{};
    for (int i = 0; i < 15; ++i) a.in[i] = (const float*)d_in[i];
    a.out = (float*)d_out; a.ws = (unsigned char*)d_ws;
    for (int j = 0; j < 8; ++j) a.invf[j] = powf(500000.0f, -(float)(2 * j) / 16.0f);
    void* kargs[] = {&a};
    hipError_t e = hipLaunchCooperativeKernel((const void*)fwd_mega, dim3(grid), dim3(NWAVES * 64), kargs, LDS_BYTES, stream);
    if (e != hipSuccess) fprintf(stderr, "kernel_launch: cooperative launch failed: %s (grid %d)\n", hipGetErrorString(e), grid);
}
```

```cpp
#include <hip/hip_runtime.h>
#include <hip/hip_cooperative_groups.h>
#include <cstdio>
#include <cstdint>
#include <cmath>
namespace pg8 {
#define PG8_LAS __attribute__((address_space(3)))
typedef unsigned short bf16_t;
typedef short bf16x8 __attribute__((ext_vector_type(8)));
typedef float f32x4 __attribute__((ext_vector_type(4)));
typedef unsigned u32x4 __attribute__((ext_vector_type(4)));
constexpr int BM = 256, BK = 64, HALF = 128, HTB = HALF * BK * 2  , STAGE_BYTES = 8 * HTB, NXCD = 8, WGM = 8;

__host__ __device__ __forceinline__ int lds_byte(int r, int c) { const int st = (r >> 4) * 2 + (c >> 5), rr = r & 15, cc = c & 31, ob = rr * 64 + cc * 2; return st * 1024 + (ob ^ (((ob >> 9) & 1) << 5)); }
__host__ __device__ __forceinline__ void stage_rc(int b, int& R, int& C) { const int st = b / 1024, sb = b % 1024, swz = sb ^ (((sb >> 9) & 1) << 5); R = (st >> 1) * 16 + swz / 64; C = (st & 1) * 32 + (swz % 64) / 2; }
__host__ __device__ __forceinline__ int perm32(int rho) { const int n = rho >> 4, i = rho & 15; return 8 * (i >> 2) + 4 * n + (i & 3); }

struct Unit { int pm, pn; };
struct Gemm { const bf16_t* A; const bf16_t* Bt; int M, N, K; };

struct StaticOrder {
    int nM, nN, nwg, G, c;
    __host__ __device__ void init(int M, int N, int G_, int c_) { nM = M / BM; nN = N / BM; nwg = nM * nN; G = G_; c = c_; }
    __host__ __device__ bool next(int i, Unit& u) const {
        const long L = (long)i * G + c; if (L >= nwg) return false;
        int wgid = (int)L; { const int q = nwg / NXCD, r = nwg % NXCD, xcd = wgid % NXCD, off = wgid / NXCD; wgid = (xcd < r ? xcd * (q + 1) : r * (q + 1) + (xcd - r) * q) + off; }
        const int nig = WGM * nN, gid = wgid / nig, fm = gid * WGM, gsz = (nM - fm) < WGM ? (nM - fm) : WGM;
        u.pm = fm + ((wgid % nig) % gsz); u.pn = (wgid % nig) / gsz; return true;
    }
    __device__ __forceinline__ void a_ready(const Unit&) const {}
    __device__ __forceinline__ void done(const Unit&) const {}
};

__device__ __forceinline__ unsigned cvt_pk_bf16(float lo, float hi) { unsigned r; asm volatile("v_cvt_pk_bf16_f32 %0, %1, %2" : "=v"(r) : "v"(lo), "v"(hi)); return r; }
typedef float f32x2 __attribute__((ext_vector_type(2)));

constexpr float kEPS = 1e-6f;
constexpr float kQSCALE = 0.125f * 1.4426950408889634f;
#define PG8_LWAIT() asm volatile("s_waitcnt lgkmcnt(0)" ::: "memory")

struct EpiQKV {
    static constexpr bool PERM = true, AFTER_DRAIN = false, HAS_MID = false;
    bf16_t* O; const float* gains; const float* rope; PG8_LAS float* xch;
    __device__ __forceinline__ void operator()(f32x4 (&acc)[2][2][4][2], const Unit& u, int wr, int wc, int fr_in, int fq_in) const {
        int fr = fr_in, fq = fq_in; asm volatile("" : "+v"(fr), "+v"(fq));
        const int seg = u.pn >> 1;
        const int row0 = u.pm * BM + wr * 64 + fr, col0 = u.pn * BM + wc * 32 + 8 * fq;
        const bool normed = (seg != 2) && (seg != 5);
        if (normed) {
#pragma unroll
            for (int ai = 0; ai < 2; ++ai)
#pragma unroll
                for (int m = 0; m < 4; ++m)
#pragma unroll
                    for (int bj = 0; bj < 2; ++bj) {
                        const f32x4 a = acc[ai][bj][m][0], b = acc[ai][bj][m][1];
                        float s = (a[0] * a[0] + a[1] * a[1]) + (a[2] * a[2] + a[3] * a[3]) + (b[0] * b[0] + b[1] * b[1]) + (b[2] * b[2] + b[3] * b[3]);
                        s += __shfl_xor(s, 16); s += __shfl_xor(s, 32);
                        if (fq == 0) xch[(ai * HALF + wr * 64 + m * 16 + fr) * 8 + (2 * bj + (wc >> 1)) * 2 + (wc & 1)] = s;
                    }
            PG8_LWAIT(); __builtin_amdgcn_s_barrier(); asm volatile("" ::: "memory");
            const float* gp = gains + 64 * ((seg == 0) ? 0 : (seg == 1) ? 1 : (seg == 3) ? 2 : 3);
            const int d0 = 32 * (wc & 1) + 8 * fq;
            const f32x4 g0 = *(const f32x4*)(gp + d0), g1 = *(const f32x4*)(gp + d0 + 4);
            const float qs = (seg == 0 || seg == 3) ? kQSCALE : 1.f;
            const bool do_rope = (seg < 2) && ((wc & 1) == 0);
#pragma unroll
            for (int ai = 0; ai < 2; ++ai)
#pragma unroll
                for (int m = 0; m < 4; ++m) {
                    const int rl = ai * HALF + wr * 64 + m * 16 + fr;
                    f32x4 c0 = {1.f, 1.f, 1.f, 1.f}, c1 = c0, s0 = {0.f, 0.f, 0.f, 0.f}, s1 = s0;
                    if (do_rope) {
                        const int t = (u.pm * BM + rl) & 4095;
                        const f32x4* rp = (const f32x4*)(rope + (size_t)t * 16);
                        c0 = rp[0]; c1 = rp[1]; s0 = rp[2]; s1 = rp[3];
                    }
#pragma unroll
                    for (int bj = 0; bj < 2; ++bj) {
                        const PG8_LAS float* xp = xch + rl * 8 + (2 * bj + (wc >> 1)) * 2;
                        const float rsq = __builtin_amdgcn_rsqf((xp[0] + xp[1]) * (1.0f / 64.0f) + kEPS);
                        f32x4 v0 = acc[ai][bj][m][0] * rsq * g0, v1 = acc[ai][bj][m][1] * rsq * g1;
                        if (do_rope) {
                            f32x4 p0, p1;
#pragma unroll
                            for (int e = 0; e < 4; ++e) { p0[e] = __shfl_xor(v0[e], 16); p1[e] = __shfl_xor(v1[e], 16); }
                            const float sg = (fq == 0) ? -1.f : 1.f;
                            if (fq < 2) { v0 = v0 * c0 + p0 * s0 * sg; v1 = v1 * c1 + p1 * s1 * sg; }
                        }
                        v0 = v0 * qs; v1 = v1 * qs;
                        u32x4 w; w.x = cvt_pk_bf16(v0[0], v0[1]); w.y = cvt_pk_bf16(v0[2], v0[3]); w.z = cvt_pk_bf16(v1[0], v1[1]); w.w = cvt_pk_bf16(v1[2], v1[3]);
                        *(u32x4*)(O + (size_t)(row0 + ai * HALF + m * 16) * 3072 + col0 + bj * HALF) = w;
                    }
                    asm volatile("" ::: "memory");
                }
        } else {
#pragma unroll
            for (int ai = 0; ai < 2; ++ai)
#pragma unroll
                for (int m = 0; m < 4; ++m)
#pragma unroll
                    for (int bj = 0; bj < 2; ++bj) {
                        const f32x4 v0 = acc[ai][bj][m][0], v1 = acc[ai][bj][m][1];
                        u32x4 w; w.x = cvt_pk_bf16(v0[0], v0[1]); w.y = cvt_pk_bf16(v0[2], v0[3]); w.z = cvt_pk_bf16(v1[0], v1[1]); w.w = cvt_pk_bf16(v1[2], v1[3]);
                        *(u32x4*)(O + (size_t)(row0 + ai * HALF + m * 16) * 3072 + col0 + bj * HALF) = w;
                    }
        }
    }
};

struct EpiRelu2 {
    static constexpr bool PERM = true, AFTER_DRAIN = false, HAS_MID = false;
    bf16_t* O; int ldc;
    __device__ __forceinline__ void operator()(f32x4 (&acc)[2][2][4][2], const Unit& u, int wr, int wc, int fr_in, int fq_in) const {
        int fr = fr_in, fq = fq_in; asm volatile("" : "+v"(fr), "+v"(fq));
        const int row0 = u.pm * BM + wr * 64 + fr, col0 = u.pn * BM + wc * 32 + 8 * fq;
#pragma unroll
        for (int ai = 0; ai < 2; ++ai)
#pragma unroll
            for (int m = 0; m < 4; ++m)
#pragma unroll
                for (int bj = 0; bj < 2; ++bj) {
                    f32x4 v0 = acc[ai][bj][m][0], v1 = acc[ai][bj][m][1];
#pragma unroll
                    for (int e = 0; e < 4; ++e) { const float a = fmaxf(v0[e], 0.f), b = fmaxf(v1[e], 0.f); v0[e] = a * a; v1[e] = b * b; }
                    u32x4 w; w.x = cvt_pk_bf16(v0[0], v0[1]); w.y = cvt_pk_bf16(v0[2], v0[3]); w.z = cvt_pk_bf16(v1[0], v1[1]); w.w = cvt_pk_bf16(v1[2], v1[3]);
                    *(u32x4*)(O + (size_t)(row0 + ai * HALF + m * 16) * ldc + col0 + bj * HALF) = w;
                }
    }
};

struct EpiOut {
    static constexpr bool PERM = false, AFTER_DRAIN = false, HAS_MID = true;
    const float* x; float* x1; const float* ga; float* ssq2; const PG8_LAS float* tab;
    __device__ __forceinline__ void mid(f32x4 (&acc)[2][2][4][2], int wr, int fr_in) const {
        int fr = fr_in; asm volatile("" : "+v"(fr));
#pragma unroll
        for (int ai = 0; ai < 2; ++ai)
#pragma unroll
            for (int m = 0; m < 4; ++m) { const float r = tab[ai * HALF + wr * 64 + m * 16 + fr];
#pragma unroll
                for (int bj = 0; bj < 2; ++bj) { acc[ai][bj][m][0] *= r; acc[ai][bj][m][1] *= r; } }
    }
    __device__ __forceinline__ void operator()(f32x4 (&acc)[2][2][4][2], const Unit& u, int wr, int wc, int fr_in, int fq_in) const {
        int fr = fr_in, fq = fq_in; asm volatile("" : "+v"(fr), "+v"(fq));
        const int col0 = u.pn * BM + wc * 32 + 4 * fq; const float* gab = ga + (size_t)(u.pm >> 4) * 6144;
        f32x4 gv[2][2];
#pragma unroll
        for (int bj = 0; bj < 2; ++bj)
#pragma unroll
            for (int n = 0; n < 2; ++n) gv[bj][n] = *(const f32x4*)(gab + col0 + bj * HALF + n * 16);
#pragma unroll
        for (int ai = 0; ai < 2; ++ai)
#pragma unroll
            for (int m = 0; m < 4; ++m) { const int rl = ai * HALF + wr * 64 + m * 16 + fr; const float rf = tab[256 + rl]; const size_t off = (size_t)(u.pm * BM + rl) * 1024 + col0; float s = 0.f;
#pragma unroll
                for (int bj = 0; bj < 2; ++bj)
#pragma unroll
                    for (int n = 0; n < 2; ++n) { const f32x4 xs = *(const f32x4*)(x + off + bj * HALF + n * 16); const f32x4 o = xs + gv[bj][n] * (acc[ai][bj][m][n] * rf);
                        s += (o[0] * o[0] + o[1] * o[1]) + (o[2] * o[2] + o[3] * o[3]); *(f32x4*)(x1 + off + bj * HALF + n * 16) = o; }
                s += __shfl_xor(s, 16); s += __shfl_xor(s, 32);
                if (fq == 0) atomicAdd(ssq2 + u.pm * BM + rl, s);
                asm volatile("" ::: "memory"); }
    }
};

struct EpiFinal {
    static constexpr bool PERM = false, AFTER_DRAIN = false, HAS_MID = false;
    const float* x1; float* out; const float* gm;
    __device__ __forceinline__ void operator()(f32x4 (&acc)[2][2][4][2], const Unit& u, int wr, int wc, int fr_in, int fq_in) const {
        int fr = fr_in, fq = fq_in; asm volatile("" : "+v"(fr), "+v"(fq));
        const int col0 = u.pn * BM + wc * 32 + 4 * fq; const float* gmb = gm + (size_t)(u.pm >> 4) * 6144;
        f32x4 gv[2][2];
#pragma unroll
        for (int bj = 0; bj < 2; ++bj)
#pragma unroll
            for (int n = 0; n < 2; ++n) gv[bj][n] = *(const f32x4*)(gmb + col0 + bj * HALF + n * 16);
#pragma unroll
        for (int ai = 0; ai < 2; ++ai)
#pragma unroll
            for (int m = 0; m < 4; ++m) { const size_t off = (size_t)(u.pm * BM + ai * HALF + wr * 64 + m * 16 + fr) * 1024 + col0;
#pragma unroll
                for (int bj = 0; bj < 2; ++bj)
#pragma unroll
                    for (int n = 0; n < 2; ++n) { const f32x4 xs = *(const f32x4*)(x1 + off + bj * HALF + n * 16); *(f32x4*)(out + off + bj * HALF + n * 16) = xs + gv[bj][n] * acc[ai][bj][m][n]; }
                asm volatile("" ::: "memory"); }
    }
};
template <class Epi, class Sched, bool ALIGN_EPI = false, bool SP2 = false>
__device__ __forceinline__ void gemm_phase(PG8_LAS unsigned char* lds, const Gemm g, const Sched& S, const Epi& E) {
    const int tid = threadIdx.x, wid = __builtin_amdgcn_readfirstlane(tid >> 6), lane = tid & 63, wr = wid >> 2, wc = wid & 3, fr = lane & 15, fq = lane >> 4;
    const int K = g.K, nt = K / BK;
    unsigned voffA[2], voffB[2];
#pragma unroll
    for (int i = 0; i < 2; ++i) { int R, C; stage_rc(tid * 16 + i * 8192, R, C); const int Rb = Epi::PERM ? ((R & ~31) + perm32(R & 31)) : R;
        voffA[i] = (unsigned)(R * K + C) * 2u; voffB[i] = (unsigned)(Rb * K + C) * 2u; }
    const size_t kstep = (size_t)(BK * 2);
    const size_t hstep = (size_t)HALF * K * 2;
    const size_t tstep = 2 * hstep;
    const unsigned ldsw = (unsigned)wid * 1024u;
    const int aoff = lds_byte(wr * 64 + fr, fq * 8), boff = lds_byte(wc * 32 + fr, fq * 8);
#define PG8_SA(b, h) (((b) * 2 + (h)) * HTB)
#define PG8_SB(b, h) ((4 + (b) * 2 + (h)) * HTB)
#define PG8_STAGE(bufoff, gbase, voff) do { _Pragma("unroll") for (int _i = 0; _i < 2; ++_i) \
        __builtin_amdgcn_global_load_lds((const unsigned*)((const char*)(gbase) + (voff)[_i]), (PG8_LAS unsigned*)(lds + (bufoff) + ldsw + _i * 8192), 16, 0, 0); } while (0)
#define PG8_LDA(dst, b, h) do { _Pragma("unroll") for (int m = 0; m < 4; ++m) _Pragma("unroll") for (int k = 0; k < 2; ++k) dst[m][k] = *(const PG8_LAS bf16x8*)(lds + PG8_SA(b, h) + aoff + m * 2048 + k * 1024); } while (0)
#define PG8_LDB(dst, b, h) do { _Pragma("unroll") for (int n = 0; n < 2; ++n) _Pragma("unroll") for (int k = 0; k < 2; ++k) dst[n][k] = *(const PG8_LAS bf16x8*)(lds + PG8_SB(b, h) + boff + n * 2048 + k * 1024); } while (0)
#define PG8_MMA(ai, bj, At, Bt) do { __builtin_amdgcn_s_setprio(1); _Pragma("unroll") for (int m = 0; m < 4; ++m) _Pragma("unroll") for (int n = 0; n < 2; ++n) _Pragma("unroll") for (int k = 0; k < 2; ++k) \
        acc[ai][bj][m][n] = __builtin_amdgcn_mfma_f32_16x16x32_bf16(Bt[n][k], At[m][k], acc[ai][bj][m][n], 0, 0, 0); __builtin_amdgcn_s_setprio(0); } while (0)
#define PG8_WAIT_V(n) asm volatile("s_waitcnt vmcnt(" #n ")" ::: "memory")
#define PG8_WAIT_L(n) asm volatile("s_waitcnt lgkmcnt(" #n ")" ::: "memory")
#define PG8_BAR __builtin_amdgcn_s_barrier()
#define PG8_SCHED __builtin_amdgcn_sched_barrier(0)
    Unit cur, nxt; int ui = 0;
    if (!S.next(0, cur)) return;
    f32x4 acc[2][2][4][2];
#pragma unroll
    for (int a = 0; a < 2; ++a)
#pragma unroll
        for (int b = 0; b < 2; ++b)
#pragma unroll
            for (int m = 0; m < 4; ++m)
#pragma unroll
                for (int n = 0; n < 2; ++n) acc[a][b][m][n] = (f32x4){0.f, 0.f, 0.f, 0.f};
    bf16x8 At[4][2], B0[2][2], B1[2][2];
    const char* cA = (const char*)g.A + (size_t)cur.pm * tstep; const char* cB = (const char*)g.Bt + (size_t)cur.pn * tstep;
    S.a_ready(cur);
    if constexpr (SP2) {
        PG8_STAGE(PG8_SB(0, 0), cB, voffB); PG8_STAGE(PG8_SB(0, 1), cB + hstep, voffB); PG8_STAGE(PG8_SA(0, 0), cA, voffA); PG8_STAGE(PG8_SA(0, 1), cA + hstep, voffA);
        if (wr == 1) PG8_BAR;
        PG8_WAIT_V(2); PG8_BAR;
        PG8_STAGE(PG8_SB(1, 0), cB + kstep, voffB); PG8_STAGE(PG8_SA(1, 0), cA + kstep, voffA); PG8_STAGE(PG8_SB(1, 1), cB + hstep + kstep, voffB);
        PG8_WAIT_V(6); PG8_BAR;
    } else {
        PG8_STAGE(PG8_SB(0, 0), cB, voffB); PG8_STAGE(PG8_SA(0, 0), cA, voffA); PG8_STAGE(PG8_SB(0, 1), cB + hstep, voffB); PG8_STAGE(PG8_SA(0, 1), cA + hstep, voffA);
        if (wr == 1) PG8_BAR;
        PG8_WAIT_V(4); PG8_BAR;
        PG8_STAGE(PG8_SB(1, 0), cB + kstep, voffB); PG8_STAGE(PG8_SA(1, 0), cA + kstep, voffA); PG8_STAGE(PG8_SB(1, 1), cB + hstep + kstep, voffB);
        PG8_WAIT_V(6); PG8_BAR;
    }
    for (;;) {
        const bool has_next = S.next(ui + 1, nxt);
        const char* nA = has_next ? (const char*)g.A + (size_t)nxt.pm * tstep : cA; const char* nB = has_next ? (const char*)g.Bt + (size_t)nxt.pn * tstep : cB;
        for (int t = 0; t < nt; t += 2) {
            if constexpr (Epi::HAS_MID) { if (t == (nt >> 1)) E.mid(acc, wr, fr); }
            const bool last = (t == nt - 2);
            const char* a1 = cA + (size_t)(t + 1) * kstep;
            const char* a2 = last ? nA : cA + (size_t)(t + 2) * kstep; const char* b2 = last ? nB : cB + (size_t)(t + 2) * kstep;
            const char* a3 = a2 + kstep; const char* b3 = b2 + kstep;
            if (last && has_next) S.a_ready(nxt);
            if constexpr (SP2) {
            PG8_LDB(B0, 0, 0); PG8_LDB(B1, 0, 1); PG8_SCHED; PG8_LDA(At, 0, 0); PG8_STAGE(PG8_SA(1, 1), a1 + hstep, voffA);
            PG8_WAIT_V(8); PG8_WAIT_L(0); PG8_BAR; PG8_MMA(0, 0, At, B0); PG8_MMA(0, 1, At, B1); PG8_BAR; PG8_SCHED;
            PG8_LDA(At, 0, 1); PG8_STAGE(PG8_SB(0, 0), b2, voffB); PG8_STAGE(PG8_SB(0, 1), b2 + hstep, voffB); PG8_STAGE(PG8_SA(0, 0), a2, voffA);
            PG8_WAIT_V(8); PG8_WAIT_L(0); PG8_BAR; PG8_MMA(1, 0, At, B0); PG8_MMA(1, 1, At, B1); PG8_BAR; PG8_SCHED;
            PG8_LDB(B0, 1, 0); PG8_LDB(B1, 1, 1); PG8_SCHED; PG8_LDA(At, 1, 0); PG8_STAGE(PG8_SA(0, 1), a2 + hstep, voffA);
            PG8_WAIT_V(8); PG8_WAIT_L(0); PG8_BAR; PG8_MMA(0, 0, At, B0); PG8_MMA(0, 1, At, B1); PG8_BAR; PG8_SCHED;
            PG8_LDA(At, 1, 1); PG8_STAGE(PG8_SB(1, 0), b3, voffB); PG8_STAGE(PG8_SB(1, 1), b3 + hstep, voffB); PG8_STAGE(PG8_SA(1, 0), a3, voffA);
            PG8_WAIT_V(8); PG8_WAIT_L(0); PG8_BAR; PG8_MMA(1, 0, At, B0); PG8_MMA(1, 1, At, B1); PG8_BAR; PG8_SCHED;
            } else {
            PG8_LDB(B0, 0, 0); PG8_SCHED; PG8_LDA(At, 0, 0); PG8_STAGE(PG8_SA(1, 1), a1 + hstep, voffA);
            PG8_WAIT_L(8); PG8_BAR; PG8_WAIT_L(0); PG8_MMA(0, 0, At, B0); PG8_BAR; PG8_SCHED;
            PG8_LDB(B1, 0, 1); PG8_STAGE(PG8_SB(0, 0), b2, voffB);
            PG8_BAR; PG8_WAIT_L(0); PG8_MMA(0, 1, At, B1); PG8_BAR;
            PG8_LDA(At, 0, 1); PG8_STAGE(PG8_SA(0, 0), a2, voffA);
            PG8_BAR; PG8_WAIT_L(0); PG8_MMA(1, 0, At, B0); PG8_BAR; PG8_SCHED;
            PG8_STAGE(PG8_SB(0, 1), b2 + hstep, voffB);
            PG8_WAIT_V(6); PG8_BAR; PG8_MMA(1, 1, At, B1); PG8_BAR;
            PG8_LDB(B0, 1, 0); PG8_SCHED; PG8_LDA(At, 1, 0); PG8_STAGE(PG8_SA(0, 1), a2 + hstep, voffA);
            PG8_WAIT_L(8); PG8_BAR; PG8_WAIT_L(0); PG8_MMA(0, 0, At, B0); PG8_BAR; PG8_SCHED;
            PG8_LDB(B1, 1, 1); PG8_STAGE(PG8_SB(1, 0), b3, voffB);
            PG8_BAR; PG8_WAIT_L(0); PG8_MMA(0, 1, At, B1); PG8_BAR;
            PG8_LDA(At, 1, 1); PG8_STAGE(PG8_SA(1, 0), a3, voffA);
            PG8_BAR; PG8_WAIT_L(0); PG8_MMA(1, 0, At, B0); PG8_BAR; PG8_SCHED;
            PG8_STAGE(PG8_SB(1, 1), b3 + hstep, voffB);
            PG8_WAIT_V(6); PG8_BAR; PG8_MMA(1, 1, At, B1); PG8_BAR;
            }
        }
        if constexpr (ALIGN_EPI) { if (wr == 0) PG8_BAR; }
        if constexpr (!Epi::AFTER_DRAIN) { E(acc, cur, wr, wc, fr, fq); S.done(cur); }
        if (!has_next) break;
#pragma unroll
        for (int a = 0; a < 2; ++a)
#pragma unroll
            for (int b = 0; b < 2; ++b)
#pragma unroll
                for (int m = 0; m < 4; ++m)
#pragma unroll
                    for (int n = 0; n < 2; ++n) acc[a][b][m][n] = (f32x4){0.f, 0.f, 0.f, 0.f};
        cur = nxt; cA = nA; cB = nB; ++ui;
        if constexpr (ALIGN_EPI) { if (wr == 1) PG8_BAR; }
    }
    PG8_WAIT_V(0);
    if constexpr (!ALIGN_EPI) { if (wr == 0) PG8_BAR; }
    PG8_BAR;
    if constexpr (Epi::AFTER_DRAIN) { E.fused(acc, cur, wr, wc, fr, fq, lds, wid, lane); S.done(cur); }
#undef PG8_SA
#undef PG8_SB
#undef PG8_STAGE
#undef PG8_LDA
#undef PG8_LDB
#undef PG8_MMA
#undef PG8_WAIT_V
#undef PG8_WAIT_L
#undef PG8_BAR
#undef PG8_SCHED
}
}

namespace att {
#define ATT_LAS __attribute__((address_space(3)))
typedef unsigned short bf16_t;
typedef short bf16x8 __attribute__((ext_vector_type(8)));
typedef short s16x4 __attribute__((ext_vector_type(4)));
typedef float f32x16 __attribute__((ext_vector_type(16)));
typedef float f32x4 __attribute__((ext_vector_type(4)));
typedef unsigned u32x4 __attribute__((ext_vector_type(4)));
constexpr int SEQ = 4096, NQKV = 3072;
constexpr int ROWB = 144;
constexpr int TILEB = 64 * ROWB;
constexpr int L_K = 0, L_V = 2 * TILEB, L_CK = 4 * TILEB, L_KMH = L_CK + 512, L_KML = L_KMH + 32 * ROWB, L_WS = L_KML + 32 * ROWB, L_END = L_WS + 8 * 256;
constexpr float NEG = -1.0e30f;
__device__ __forceinline__ unsigned cvtpk(float lo, float hi) { unsigned r; asm volatile("v_cvt_pk_bf16_f32 %0, %1, %2" : "=v"(r) : "v"(lo), "v"(hi)); return r; }
__device__ __forceinline__ s16x4 vtr(const ATT_LAS unsigned char* p) { return __builtin_bit_cast(s16x4, __builtin_amdgcn_ds_read_tr16_b64_v4i16((ATT_LAS s16x4*)p)); }
__device__ __forceinline__ unsigned f2bf(float f) { unsigned u = __builtin_bit_cast(unsigned, f); return (u + 0x7fffu + ((u >> 16) & 1u)) >> 16; }

template <bool FOX>
__device__ __forceinline__ void attn_unit(int b, int h, int qb, const bf16_t* __restrict__ QKV, const float* __restrict__ cl, const float* __restrict__ kmean,
                                          bf16_t* __restrict__ O, float* __restrict__ ssq, ATT_LAS unsigned char* lds) {
    const int tid = threadIdx.x, lane = tid & 63, r32 = lane & 31, hi = lane >> 5;
    const int wid = __builtin_amdgcn_readfirstlane(tid >> 6);
    const int qcol = FOX ? 1536 + h * 64 : h * 64, kcol = qcol + 512, vcol = qcol + 1024, ocol = FOX ? 512 + h * 64 : h * 64;
    const size_t rowbase = (size_t)b * SEQ; const int q0 = qb * 256;
    const int qpos = q0 + wid * 32 + r32;
    bf16x8 qr[4];
    { const bf16_t* qp = QKV + (rowbase + qpos) * NQKV + qcol + hi * 8;
#pragma unroll
      for (int d0 = 0; d0 < 4; ++d0) qr[d0] = *(const bf16x8*)(qp + d0 * 16); }
    const int lrow = tid >> 3, lch = tid & 7;
    const bf16_t* ksrc = QKV + (rowbase + lrow) * NQKV + kcol + lch * 8;
    const bf16_t* vsrc = QKV + (rowbase + lrow) * NQKV + vcol + lch * 8;
    const int ldst = lrow * ROWB + lch * 16;
    const float* clh = cl + (size_t)(b * 8 + h) * SEQ;
    float cq = 0.f; if (FOX) cq = clh[qpos];
    unsigned sel = 0xffffffffu;
    ATT_LAS float* wsf = (ATT_LAS float*)(lds + L_WS) + wid * 64;
    if (!FOX) {
        { const float* km = kmean + (size_t)(b * 8 + h) * 1024;
          const int i0 = tid * 2, n = i0 >> 6, d = i0 & 63;
          const float v0 = km[i0], v1 = km[i0 + 1];
          const unsigned h0 = f2bf(v0), h1 = f2bf(v1);
          const float r0 = v0 - __uint_as_float(h0 << 16), r1 = v1 - __uint_as_float(h1 << 16);
          *(ATT_LAS unsigned*)(lds + L_KMH + n * ROWB + d * 2) = h0 | (h1 << 16);
          *(ATT_LAS unsigned*)(lds + L_KML + n * ROWB + d * 2) = f2bf(r0) | (f2bf(r1) << 16);
          *(ATT_LAS unsigned*)(lds + L_KMH + (16 + n) * ROWB + d * 2) = 0u;
          *(ATT_LAS unsigned*)(lds + L_KML + (16 + n) * ROWB + d * 2) = 0u; }
        __syncthreads();
        f32x16 g = {};
#pragma unroll
        for (int d0 = 0; d0 < 4; ++d0) {
            const bf16x8 kh = *(const ATT_LAS bf16x8*)(lds + L_KMH + r32 * ROWB + (d0 * 16 + hi * 8) * 2);
            const bf16x8 kl = *(const ATT_LAS bf16x8*)(lds + L_KML + r32 * ROWB + (d0 * 16 + hi * 8) * 2);
            g = __builtin_amdgcn_mfma_f32_32x32x16_bf16(kh, qr[d0], g, 0, 0, 0);
            g = __builtin_amdgcn_mfma_f32_32x32x16_bf16(kl, qr[d0], g, 0, 0, 0);
        }
        float G[16];
#pragma unroll
        for (int n = 0; n < 16; ++n) { const int r = (n & 3) + 4 * (n >> 3); const float mine = g[r], oth = __shfl_xor(g[r], 32); G[n] = (((n >> 2) & 1) == hi) ? mine : oth; }
        sel = 0u;
#pragma unroll
        for (int pass = 0; pass < 3; ++pass) {
            float best = -INFINITY; int bi = -1;
#pragma unroll
            for (int n = 0; n < 16; ++n) { const bool ok = (n < qb) && (((sel >> n) & 1u) == 0u) && (G[n] > best); if (ok) { best = G[n]; bi = n; } }
            if (bi >= 0) sel |= (1u << bi);
        }
    }
    const int NT = 4 * (qb + 1);
    u32x4 kreg = *(const u32x4*)ksrc, vreg = *(const u32x4*)vsrc; float ckr = 0.f;
    if (FOX && tid < 64) ckr = clh[tid];
    *(ATT_LAS u32x4*)(lds + L_K + ldst) = kreg; *(ATT_LAS u32x4*)(lds + L_V + ldst) = vreg;
    if (FOX && tid < 64) *(ATT_LAS float*)(lds + L_CK + tid * 4) = ckr;
    __syncthreads();
    float m_run = NEG, l_run = 0.f; f32x16 o0 = {}, o1 = {};
    const int vrow = 4 * hi + ((lane & 15) >> 2), vcb = (16 * ((lane >> 4) & 1) + 4 * (lane & 3)) * 2;
    for (int t = 0; t < NT; ++t) {
        const int buf = t & 1;
        if (t + 1 < NT) {
            kreg = *(const u32x4*)(ksrc + (size_t)(t + 1) * 64 * NQKV); vreg = *(const u32x4*)(vsrc + (size_t)(t + 1) * 64 * NQKV);
            if (FOX && tid < 64) ckr = clh[(t + 1) * 64 + tid];
        }
        const int blk = t >> 2, jb = t & 3; const bool diag = (blk == qb);
        bool act = !(diag && (64 * jb > 32 * wid + 31));
        bool allowed = true;
        if (!FOX && !diag) { allowed = ((sel >> blk) & 1u) != 0u; act = act && (__any(allowed ? 1 : 0) != 0); }
        if (act) {
            const ATT_LAS unsigned char* Kb = lds + L_K + buf * TILEB; const ATT_LAS unsigned char* Vb = lds + L_V + buf * TILEB;
            f32x16 p0, p1;
            if (FOX) {
                const ATT_LAS float* ck = (const ATT_LAS float*)(lds + L_CK + buf * 256);
#pragma unroll
                for (int gq = 0; gq < 4; ++gq) { const f32x4 c0 = *(const ATT_LAS f32x4*)(ck + 8 * gq + 4 * hi), c1 = *(const ATT_LAS f32x4*)(ck + 32 + 8 * gq + 4 * hi);
#pragma unroll
                    for (int e = 0; e < 4; ++e) { p0[4 * gq + e] = cq - c0[e]; p1[4 * gq + e] = cq - c1[e]; } }
            } else { p0 = (f32x16){}; p1 = (f32x16){}; }
#pragma unroll
            for (int d0 = 0; d0 < 4; ++d0) {
                const bf16x8 k0 = *(const ATT_LAS bf16x8*)(Kb + r32 * ROWB + (d0 * 16 + hi * 8) * 2);
                const bf16x8 k1 = *(const ATT_LAS bf16x8*)(Kb + (32 + r32) * ROWB + (d0 * 16 + hi * 8) * 2);
                p0 = __builtin_amdgcn_mfma_f32_32x32x16_bf16(k0, qr[d0], p0, 0, 0, 0);
                p1 = __builtin_amdgcn_mfma_f32_32x32x16_bf16(k1, qr[d0], p1, 0, 0, 0);
            }
            if (diag) {
                const int kv0 = jb * 64 + 4 * hi, qrel = wid * 32 + r32;
#pragma unroll
                for (int r = 0; r < 16; ++r) { const int kv = kv0 + (r & 3) + 8 * (r >> 2); if (kv > qrel) p0[r] = NEG; if (kv + 32 > qrel) p1[r] = NEG; }
            } else if (!FOX) {
                if (!allowed) {
#pragma unroll
                    for (int r = 0; r < 16; ++r) { p0[r] = NEG; p1[r] = NEG; } }
            }
            float mx = fmaxf(p0[0], p1[0]);
#pragma unroll
            for (int r = 1; r < 16; ++r) mx = fmaxf(mx, fmaxf(p0[r], p1[r]));
            mx = fmaxf(mx, __shfl_xor(mx, 32));
            const float m_new = fmaxf(m_run, mx);
            const float alpha = __builtin_amdgcn_exp2f(m_run - m_new); m_run = m_new;
            float ls = 0.f;
#pragma unroll
            for (int r = 0; r < 16; ++r) { p0[r] = __builtin_amdgcn_exp2f(p0[r] - m_new); p1[r] = __builtin_amdgcn_exp2f(p1[r] - m_new); ls += p0[r] + p1[r]; }
            l_run = l_run * alpha + ls;
            if (__any(alpha != 1.0f ? 1 : 0)) {
                if (hi == 0) wsf[r32] = alpha;
                asm volatile("s_waitcnt lgkmcnt(0)" ::: "memory");
#pragma unroll
                for (int gq = 0; gq < 4; ++gq) { const f32x4 a = *(const ATT_LAS f32x4*)(wsf + 8 * gq + 4 * hi);
#pragma unroll
                    for (int e = 0; e < 4; ++e) { o0[4 * gq + e] *= a[e]; o1[4 * gq + e] *= a[e]; } }
            }
#pragma unroll
            for (int c = 0; c < 2; ++c)
#pragma unroll
                for (int uu = 0; uu < 2; ++uu) {
                    u32x4 pw;
                    if (c == 0) { pw.x = cvtpk(p0[8 * uu + 0], p0[8 * uu + 1]); pw.y = cvtpk(p0[8 * uu + 2], p0[8 * uu + 3]); pw.z = cvtpk(p0[8 * uu + 4], p0[8 * uu + 5]); pw.w = cvtpk(p0[8 * uu + 6], p0[8 * uu + 7]); }
                    else        { pw.x = cvtpk(p1[8 * uu + 0], p1[8 * uu + 1]); pw.y = cvtpk(p1[8 * uu + 2], p1[8 * uu + 3]); pw.z = cvtpk(p1[8 * uu + 4], p1[8 * uu + 5]); pw.w = cvtpk(p1[8 * uu + 6], p1[8 * uu + 7]); }
                    const bf16x8 pa = __builtin_bit_cast(bf16x8, pw);
                    const ATT_LAS unsigned char* vp = Vb + (32 * c + 16 * uu + vrow) * ROWB + vcb;
                    const s16x4 a0 = vtr(vp), a1 = vtr(vp + 8 * ROWB), b0 = vtr(vp + 64), b1 = vtr(vp + 8 * ROWB + 64);
                    const bf16x8 vf0 = {a0[0], a0[1], a0[2], a0[3], a1[0], a1[1], a1[2], a1[3]};
                    const bf16x8 vf1 = {b0[0], b0[1], b0[2], b0[3], b1[0], b1[1], b1[2], b1[3]};
                    o0 = __builtin_amdgcn_mfma_f32_32x32x16_bf16(pa, vf0, o0, 0, 0, 0);
                    o1 = __builtin_amdgcn_mfma_f32_32x32x16_bf16(pa, vf1, o1, 0, 0, 0);
                }
        }
        if (t + 1 < NT) {
            *(ATT_LAS u32x4*)(lds + L_K + (buf ^ 1) * TILEB + ldst) = kreg; *(ATT_LAS u32x4*)(lds + L_V + (buf ^ 1) * TILEB + ldst) = vreg;
            if (FOX && tid < 64) *(ATT_LAS float*)(lds + L_CK + (buf ^ 1) * 256 + tid * 4) = ckr;
        }
        __syncthreads();
    }
    l_run += __shfl_xor(l_run, 32);
    if (hi == 0) wsf[r32] = 1.0f / l_run;
    asm volatile("s_waitcnt lgkmcnt(0)" ::: "memory");
    bf16_t* Ow = O + (rowbase + q0 + wid * 32) * 1024 + ocol + r32;
    float* sq = ssq + (FOX ? 16384 : 0) + rowbase + q0 + wid * 32;
#pragma unroll
    for (int gq = 0; gq < 4; ++gq) { const f32x4 a = *(const ATT_LAS f32x4*)(wsf + 8 * gq + 4 * hi);
#pragma unroll
        for (int e = 0; e < 4; ++e) { const int r = 4 * gq + e, row = 8 * gq + 4 * hi + e;
            const unsigned w0 = f2bf(o0[r] * a[e]), w1 = f2bf(o1[r] * a[e]);
            Ow[(size_t)row * 1024] = (bf16_t)w0; Ow[(size_t)row * 1024 + 32] = (bf16_t)w1;
            const float f0 = __uint_as_float(w0 << 16), f1 = __uint_as_float(w1 << 16);
            float s = f0 * f0 + f1 * f1;
            s += __shfl_xor(s, 1); s += __shfl_xor(s, 2); s += __shfl_xor(s, 4); s += __shfl_xor(s, 8); s += __shfl_xor(s, 16);
            if (r32 == 0) atomicAdd(sq + row, s); } }
    __syncthreads();
}
}

namespace cg = cooperative_groups;
#define LAS __attribute__((address_space(3)))
typedef unsigned short bf16;
typedef unsigned v4u __attribute__((ext_vector_type(4)));
typedef float f32x4 __attribute__((ext_vector_type(4)));
constexpr int NWAVES = 8;
constexpr int BATCH = 4, SEQ = 4096, D = 1024, M = BATCH * SEQ, NQKV = 3072, INW = 3080, FF = 4096, NHG = 8;
constexpr float EPS = 1e-6f, LOG2E = 1.4426950408889634f;
constexpr size_t MiB = 1u << 20;
constexpr size_t WS_CTL = 0, CTL_ZERO_BYTES = 1 * MiB;
constexpr size_t OFF_MOD = 64 * 1024;
constexpr size_t OFF_KMEAN = 256 * 1024;
constexpr size_t OFF_SSQO = 512 * 1024;
constexpr size_t OFF_SSQ2 = 768 * 1024;
constexpr size_t WS_GAINS = 3 * MiB;
constexpr size_t WS_ROPE = 1 * MiB;
constexpr size_t WS_LOGF = 2 * MiB;
constexpr size_t WS_CUM = WS_LOGF + 512 * 1024;
constexpr size_t WS_WIN = 4 * MiB, WS_WOUT = 10 * MiB, WS_W1 = 12 * MiB, WS_W2 = 20 * MiB;
constexpr size_t WS_XN = 32 * MiB;
constexpr size_t WS_QKV = 64 * MiB;
constexpr size_t WS_O = 160 * MiB;
constexpr size_t WS_X1 = 192 * MiB;
constexpr size_t WS_H = 64 * MiB;
constexpr size_t WS_END = 256 * MiB;
constexpr int RING_BYTES = 131072, XOFF = RING_BYTES, MISC_OFF = RING_BYTES + 24576, LDS_BYTES = MISC_OFF + 256;
constexpr int CW_BAR = 4096;

__device__ __forceinline__ unsigned f2bf(float f) { unsigned u = __builtin_bit_cast(unsigned, f); return (u + 0x7fffu + ((u >> 16) & 1u)) >> 16; }
__device__ __forceinline__ unsigned pk2(float lo, float hi) { return f2bf(lo) | (f2bf(hi) << 16); }
__device__ __forceinline__ float wave_sum(float v) {
#pragma unroll
    for (int o = 1; o < 64; o <<= 1) v += __shfl_xor(v, o);
    return v;
}
__device__ __forceinline__ void transpose_item(const float* W, int ldw, int nblk, int K, bf16* WT, LAS float* scr, int item, int lane, const float* g0, const float* g1) {
    const int kb = item / nblk, nb = item % nblk, k0 = 64 * kb, n0 = 32 * nb;
#pragma unroll 8
    for (int i = 0; i < 32; ++i) { const int kk = 2 * i + (lane >> 5); float v = W[(size_t)(k0 + kk) * ldw + n0 + (lane & 31)];
        if (g0) { const int k = k0 + kk; v *= (k < 512) ? g0[k] : g1[k - 512]; }
        scr[kk * 33 + (lane & 31)] = v; }
    asm volatile("s_waitcnt lgkmcnt(0)" ::: "memory");
    const int c = lane & 7;
#pragma unroll
    for (int j = 0; j < 4; ++j) { const int n = (lane >> 3) + 8 * j; const LAS float* s = scr + (8 * c) * 33 + n;
        v4u o; o.x = pk2(s[0 * 33], s[1 * 33]); o.y = pk2(s[2 * 33], s[3 * 33]); o.z = pk2(s[4 * 33], s[5 * 33]); o.w = pk2(s[6 * 33], s[7 * 33]);
        *(v4u*)(WT + (size_t)(n0 + n) * K + k0 + 8 * c) = o; }
    asm volatile("s_waitcnt lgkmcnt(0)" ::: "memory");
}
__device__ __forceinline__ void cossin_acc(float ang, float& c, float& s) {
    double r = (double)ang; const double n = __builtin_rint(r * 0.15915494309189535); r = __builtin_fma(-n, 6.283185307179586, r);
    const double r2 = r * r;
    double ps = -1.0 / 51090942171709440000.0;
    ps = ps * r2 + 1.0 / 121645100408832000.0;
    ps = ps * r2 - 1.0 / 355687428096000.0;
    ps = ps * r2 + 1.0 / 1307674368000.0;
    ps = ps * r2 - 1.0 / 6227020800.0;
    ps = ps * r2 + 1.0 / 39916800.0;
    ps = ps * r2 - 1.0 / 362880.0;
    ps = ps * r2 + 1.0 / 5040.0;
    ps = ps * r2 - 1.0 / 120.0;
    ps = ps * r2 + 1.0 / 6.0;
    s = (float)(r - r * r2 * ps);
    double pc = 1.0 / 2432902008176640000.0;
    pc = pc * r2 - 1.0 / 6402373705728000.0;
    pc = pc * r2 + 1.0 / 20922789888000.0;
    pc = pc * r2 - 1.0 / 87178291200.0;
    pc = pc * r2 + 1.0 / 479001600.0;
    pc = pc * r2 - 1.0 / 3628800.0;
    pc = pc * r2 + 1.0 / 40320.0;
    pc = pc * r2 - 1.0 / 720.0;
    pc = pc * r2 + 1.0 / 24.0;
    pc = pc * r2 - 0.5;
    c = (float)(1.0 + r2 * pc);
}


#define XB_TMO      128
#define XB_XCNT(j)  (256  + 64 * (j))
#define XB_XSUB(j)  (1280 + 64 * (j))
#define XB_XGEN(j)  (2304 + 64 * (j))
#define XB_TOP      3328
#define XB_TOPGEN   3392
#define XCD_BAR_WORDS 3456
#define XB_SPIN_CAP (1u << 18)

__device__ __forceinline__ unsigned xb_ld(unsigned* p)              { return __hip_atomic_load(p, __ATOMIC_RELAXED, __HIP_MEMORY_SCOPE_AGENT); }
__device__ __forceinline__ unsigned xb_add(unsigned* p, unsigned v) { return __hip_atomic_fetch_add(p, v, __ATOMIC_RELAXED, __HIP_MEMORY_SCOPE_AGENT); }
__device__ __forceinline__ unsigned xb_xcc_id() { return (unsigned)__builtin_amdgcn_s_getreg((3 << 11) | 20) & 0xFu; }
#define XB_SPIN(cond, bar) do { unsigned _sp = 0; while (cond) { __builtin_amdgcn_s_sleep(1); \
    if ((++_sp & 255u) == 0u) { if (xb_ld(&(bar)[XB_TMO])) break; if (_sp > XB_SPIN_CAP) { atomicAdd(&(bar)[XB_TMO], 1u); break; } } } } while (0)

struct XcdBarrier {
    unsigned* bar; unsigned x;
    volatile LAS unsigned* st;
};

__device__ __forceinline__ XcdBarrier xcd_barrier_post(unsigned* bar, volatile LAS unsigned* st) {
    XcdBarrier b; b.bar = bar; b.x = xb_xcc_id(); b.st = st;
    if (threadIdx.x == 0) (void)xb_add(&bar[XB_XCNT(b.x)], 1u);
    return b;
}
__device__ __forceinline__ void xcd_barrier_complete(unsigned* bar, unsigned x, unsigned& nloc, unsigned& nx) {
    const unsigned G = gridDim.x * gridDim.y * gridDim.z;
    unsigned sum, cnt, mine, sp = 0u;
    for (;;) {
        sum = 0u; cnt = 0u; mine = 0u;
#pragma unroll
        for (unsigned j = 0; j < 16; ++j) { const unsigned c = xb_ld(&bar[XB_XCNT(j)]); sum += c; cnt += (c > 0u) ? 1u : 0u; mine = (j == x) ? c : mine; }
        if (sum == G) break;
        __builtin_amdgcn_s_sleep(1);
        if ((++sp & 255u) == 0u) { if (xb_ld(&bar[XB_TMO])) break; if (sp > XB_SPIN_CAP) { atomicAdd(&bar[XB_TMO], 1u); break; } }
    }
    nloc = mine > 0u ? mine : 1u; nx = cnt > 0u ? cnt : 1u;
}

__device__ __forceinline__ void xcd_barrier(const XcdBarrier& b) {
    asm volatile("s_waitcnt vmcnt(0)" ::: "memory");
    __syncthreads();
    if (threadIdx.x == 0) {
        unsigned* bar = b.bar;
        __builtin_amdgcn_s_waitcnt(0);
        unsigned nloc = b.st[0], nx = b.st[1];
        if (nloc == 0u) { xcd_barrier_complete(bar, b.x, nloc, nx); b.st[0] = nloc; b.st[1] = nx; }
        const unsigned old = xb_add(&bar[XB_XSUB(b.x)], 1u);
        const unsigned gen = old / nloc;
        if (old + 1u == (gen + 1u) * nloc) {
            __builtin_amdgcn_fence(__ATOMIC_RELEASE, "agent");
            asm volatile("s_waitcnt vmcnt(0)" ::: "memory");
            const unsigned og = xb_add(&bar[XB_TOP], 1u);
            const unsigned tg = og / nx;
            if (og + 1u == (tg + 1u) * nx) xb_add(&bar[XB_TOPGEN], 1u);
            else XB_SPIN(xb_ld(&bar[XB_TOPGEN]) == tg, bar);
            __builtin_amdgcn_fence(__ATOMIC_ACQUIRE, "agent");
            xb_add(&bar[XB_XGEN(b.x)], 1u);
            asm volatile("s_waitcnt vmcnt(0)" ::: "memory");
        } else {
            XB_SPIN(xb_ld(&bar[XB_XGEN(b.x)]) == gen, bar);
            __builtin_amdgcn_fence(__ATOMIC_ACQUIRE, "agent");
            asm volatile("s_waitcnt vmcnt(0)" ::: "memory");
        }
    }
    __syncthreads();
}

struct Args { const float* in[15]; float* out; unsigned char* ws; float invf[8]; };

__global__ void __launch_bounds__(NWAVES * 64, 2) fwd_mega(Args args) {
    extern __shared__ __attribute__((aligned(16))) unsigned char lds_raw[];
    LAS unsigned char* lds = (LAS unsigned char*)lds_raw;
    cg::grid_group grid = cg::this_grid();
    const int tid = threadIdx.x, lane = tid & 63, wave = __builtin_amdgcn_readfirstlane(tid >> 6);
    const int G = gridDim.x, bx = blockIdx.x;
    const int vcu = (G % 8 == 0) ? (bx % 8) * (G / 8) + bx / 8 : bx;
    const int gw = vcu * NWAVES + wave, NGW = G * NWAVES;
    unsigned char* ws = args.ws;
    const float* x = args.in[0]; const float* cin = args.in[1]; const float* w_ada = args.in[2]; const float* b_ada = args.in[3]; const float* w_in = args.in[4];
    const float* b_forget = args.in[5]; const float* g_qn_moba = args.in[6]; const float* g_kn_moba = args.in[7]; const float* g_qn_fox = args.in[8]; const float* g_kn_fox = args.in[9];
    const float* g_out_moba = args.in[10]; const float* g_out_fox = args.in[11]; const float* w_out = args.in[12]; const float* w_ff1 = args.in[13]; const float* w_ff2 = args.in[14];
    float* mod = (float*)(ws + OFF_MOD); float* kmean = (float*)(ws + OFF_KMEAN); float* ssqo = (float*)(ws + OFF_SSQO); float* ssq2 = (float*)(ws + OFF_SSQ2);
    float* gains4 = (float*)(ws + WS_GAINS); float* rope = (float*)(ws + WS_ROPE); float* logf_ = (float*)(ws + WS_LOGF); float* cum = (float*)(ws + WS_CUM);
    bf16* Win_t = (bf16*)(ws + WS_WIN); bf16* Wout_t = (bf16*)(ws + WS_WOUT); bf16* W1_t = (bf16*)(ws + WS_W1); bf16* W2_t = (bf16*)(ws + WS_W2);
    bf16* XN = (bf16*)(ws + WS_XN); bf16* QKV = (bf16*)(ws + WS_QKV); bf16* OB = (bf16*)(ws + WS_O); float* X1 = (float*)(ws + WS_X1); bf16* HB = (bf16*)(ws + WS_H);
    volatile LAS unsigned* MISC = (volatile LAS unsigned*)(lds + MISC_OFF);
    if (tid < 64) MISC[tid] = 0u;
    __syncthreads();
    XcdBarrier xbar = xcd_barrier_post((unsigned*)(ws + WS_CTL) + CW_BAR, MISC + 8);
#define GRID_BAR() xcd_barrier(xbar)

#ifndef NO_P0A
    {
        LAS float* sc = (LAS float*)(lds + XOFF);
        for (int i = tid; i < 4096; i += NWAVES * 64) { const float v = cin[i]; sc[i] = v / (1.f + __expf(-v)); }
        __syncthreads();
        for (int it = gw; it < 1536; it += NGW) {
            const int cb = it % 96, kc = it / 96, col = 64 * cb + lane;
            float a0 = 0.f, a1 = 0.f, a2 = 0.f, a3 = 0.f;
#pragma unroll 8
            for (int k = 64 * kc; k < 64 * kc + 64; ++k) { const float w = w_ada[(size_t)k * 6144 + col]; a0 += sc[k] * w; a1 += sc[1024 + k] * w; a2 += sc[2048 + k] * w; a3 += sc[3072 + k] * w; }
            if (kc == 0) { const float bb = b_ada[col]; a0 += bb; a1 += bb; a2 += bb; a3 += bb; }
            atomicAdd(mod + col, a0); atomicAdd(mod + 6144 + col, a1); atomicAdd(mod + 2 * 6144 + col, a2); atomicAdd(mod + 3 * 6144 + col, a3);
        }
        if (bx == 0 && tid < 256) { const float* gsrc = (tid < 64) ? g_qn_moba : (tid < 128) ? g_kn_moba : (tid < 192) ? g_qn_fox : g_kn_fox; gains4[tid] = gsrc[tid & 63]; }
        LAS float* scr = (LAS float*)(lds + wave * 16384);
        constexpr int I_IN = 16 * 96, I_O = 16 * 32, I_1 = 16 * 128, I_2 = 64 * 32, NITEMS = I_IN + I_O + I_1 + I_2;
        for (int it = gw; it < NITEMS; it += NGW) {
            int r = it;
            if (r < I_IN) { transpose_item(w_in, INW, 96, D, Win_t, scr, r, lane, nullptr, nullptr); continue; } r -= I_IN;
            if (r < I_O) { transpose_item(w_out, D, 32, D, Wout_t, scr, r, lane, g_out_moba, g_out_fox); continue; } r -= I_O;
            if (r < I_1) { transpose_item(w_ff1, FF, 128, D, W1_t, scr, r, lane, nullptr, nullptr); continue; } r -= I_1;
            transpose_item(w_ff2, D, 32, FF, W2_t, scr, r, lane, nullptr, nullptr);
        }
        for (int i = (vcu * NWAVES * 64) + tid; i < 4096 * 8; i += G * NWAVES * 64) { const int t = i >> 3, j = i & 7; float c, s; cossin_acc((float)t * args.invf[j], c, s); rope[t * 16 + j] = c; rope[t * 16 + 8 + j] = s; }
    }
#endif
    grid.sync();

#ifndef NO_P0B
    {
        LAS float* wf = (LAS float*)lds;
        for (int i = tid; i < 8192; i += NWAVES * 64) { const int k = i >> 3, hh = i & 7; wf[hh * 1024 + k] = w_in[(size_t)k * INW + 3072 + hh]; }
        __syncthreads();
        for (int m = gw; m < M; m += NGW) {
            const int b = m >> 12, t = m & 4095; const float* mb = mod + (size_t)b * 6144;
            const f32x4* xr = (const f32x4*)(x + (size_t)m * D) + lane;
            f32x4 v[4]; float s = 0.f;
#pragma unroll
            for (int j = 0; j < 4; ++j) { v[j] = xr[64 * j]; s += (v[j].x * v[j].x + v[j].y * v[j].y) + (v[j].z * v[j].z + v[j].w * v[j].w); }
            const float rs = 1.0f / sqrtf(wave_sum(s) * (1.f / D) + EPS);
            float fl[8];
#pragma unroll
            for (int hh = 0; hh < 8; ++hh) fl[hh] = 0.f;
            unsigned long long* o8 = (unsigned long long*)(XN + (size_t)m * D) + lane;
#pragma unroll
            for (int j = 0; j < 4; ++j) { const int col = 4 * lane + 256 * j;
                const f32x4 sh = *(const f32x4*)(mb + col), scl = *(const f32x4*)(mb + 1024 + col);
                const f32x4 hv = v[j] * rs * (scl + 1.0f) + sh;
                o8[64 * j] = (unsigned long long)pk2(hv.x, hv.y) | ((unsigned long long)pk2(hv.z, hv.w) << 32);
#pragma unroll
                for (int hh = 0; hh < 8; ++hh) { const f32x4 w = *(const LAS f32x4*)(wf + hh * 1024 + col); fl[hh] += (hv.x * w.x + hv.y * w.y) + (hv.z * w.z + hv.w * w.w); } }
#pragma unroll
            for (int hh = 0; hh < 8; ++hh) fl[hh] = wave_sum(fl[hh]);
            float mine = fl[0];
#pragma unroll
            for (int hh = 1; hh < 8; ++hh) mine = (lane == hh) ? fl[hh] : mine;
            if (lane < 8) { const float z = mine + b_forget[lane]; const float ls = fminf(z, 0.f) - log1pf(__expf(-fabsf(z))); logf_[(size_t)(b * 8 + lane) * SEQ + t] = ls; }
        }
    }
#endif
    GRID_BAR();

#ifndef NO_P1
    {
        if (bx < 32) {
            LAS float* wt = (LAS float*)(lds + XOFF);
            const float* src = logf_ + (size_t)bx * SEQ + tid * 8;
            const f32x4 a = *(const f32x4*)src, b2 = *(const f32x4*)(src + 4);
            float p[8]; p[0] = a.x; p[1] = p[0] + a.y; p[2] = p[1] + a.z; p[3] = p[2] + a.w; p[4] = p[3] + b2.x; p[5] = p[4] + b2.y; p[6] = p[5] + b2.z; p[7] = p[6] + b2.w;
            float incl = p[7];
#pragma unroll
            for (int o = 1; o < 64; o <<= 1) { const float up = __shfl_up(incl, o); if (lane >= o) incl += up; }
            if (lane == 63) wt[wave] = incl;
            __syncthreads();
            float base = incl - p[7];
            for (int w = 0; w < wave; ++w) base += wt[w];
            float* dst = cum + (size_t)bx * SEQ + tid * 8;
            f32x4 o0, o1; o0.x = (base + p[0]) * LOG2E; o0.y = (base + p[1]) * LOG2E; o0.z = (base + p[2]) * LOG2E; o0.w = (base + p[3]) * LOG2E;
            o1.x = (base + p[4]) * LOG2E; o1.y = (base + p[5]) * LOG2E; o1.z = (base + p[6]) * LOG2E; o1.w = (base + p[7]) * LOG2E;
            *(f32x4*)dst = o0; *(f32x4*)(dst + 4) = o1;
            __syncthreads();
        }
        pg8::Gemm g{XN, Win_t, M, NQKV, D}; pg8::StaticOrder S; S.init(M, NQKV, G, bx);
        pg8::EpiQKV E{QKV, gains4, rope, (LAS float*)(lds + XOFF)};
        pg8::gemm_phase<pg8::EpiQKV, pg8::StaticOrder, true, true>(lds, g, S, E);
        { pg8::Unit u;
          for (int i = 0; S.next(i, u); ++i) if ((u.pn >> 1) == 1) {
              const int cch = tid & 31, rg = tid >> 5;
              float s8[8];
#pragma unroll
              for (int e = 0; e < 8; ++e) s8[e] = 0.f;
#pragma unroll 4
              for (int r = 0; r < 16; ++r) { const v4u v = *(const v4u*)(QKV + (size_t)(u.pm * 256 + rg + 16 * r) * NQKV + u.pn * 256 + cch * 8);
                  s8[0] += __uint_as_float(v.x << 16); s8[1] += __uint_as_float(v.x & 0xffff0000u); s8[2] += __uint_as_float(v.y << 16); s8[3] += __uint_as_float(v.y & 0xffff0000u);
                  s8[4] += __uint_as_float(v.z << 16); s8[5] += __uint_as_float(v.z & 0xffff0000u); s8[6] += __uint_as_float(v.w << 16); s8[7] += __uint_as_float(v.w & 0xffff0000u); }
              LAS float* part = (LAS float*)lds;
#pragma unroll
              for (int e = 0; e < 8; ++e) part[rg * 256 + cch * 8 + e] = s8[e];
              __syncthreads();
              if (tid < 256) { float t = 0.f;
#pragma unroll
                  for (int r = 0; r < 16; ++r) t += part[r * 256 + tid];
                  const int head = (u.pn & 1) * 4 + (tid >> 6), b = u.pm >> 4, blk = u.pm & 15;
                  kmean[((size_t)((b * 8 + head) * 16 + blk)) * 64 + (tid & 63)] = t; }
              __syncthreads();
          } }
    }
#endif
    GRID_BAR();

#ifndef NO_P2
    {
        if (G == 256) {
            const int kbh = vcu >> 2, s4 = vcu & 3, kind = kbh >> 5, bh = kbh & 31;
            for (int i = 0; i < 4; ++i) { const int qb = (i == 0) ? 15 - 2 * s4 : (i == 1) ? 14 - 2 * s4 : (i == 2) ? 2 * s4 + 1 : 2 * s4;
                if (kind) att::attn_unit<true>(bh >> 3, bh & 7, qb, QKV, cum, kmean, OB, ssqo, lds); else att::attn_unit<false>(bh >> 3, bh & 7, qb, QKV, cum, kmean, OB, ssqo, lds); }
        } else {
            for (int u = vcu; u < 1024; u += G) { const int qb = 15 - (u & 15), kbh = u >> 4, kind = kbh >> 5, bh = kbh & 31;
                if (kind) att::attn_unit<true>(bh >> 3, bh & 7, qb, QKV, cum, kmean, OB, ssqo, lds); else att::attn_unit<false>(bh >> 3, bh & 7, qb, QKV, cum, kmean, OB, ssqo, lds); }
        }
    }
#endif
    GRID_BAR();

#ifndef NO_P3
    {
        pg8::Gemm g{OB, Wout_t, M, D, D}; pg8::StaticOrder S; S.init(M, D, G, bx);
        LAS float* tab = (LAS float*)(lds + XOFF);
        pg8::Unit u0;
        if (S.next(0, u0)) {
            if (tid < 256) { const int row = u0.pm * 256 + tid; const float rm = 1.0f / sqrtf(ssqo[row] * (1.f / 512.f) + EPS), rf = 1.0f / sqrtf(ssqo[16384 + row] * (1.f / 512.f) + EPS);
                tab[tid] = rm / rf; tab[256 + tid] = rf; }
        }
        __syncthreads();
        pg8::EpiOut E{x, X1, mod + 2048, ssq2, tab};
        pg8::gemm_phase<pg8::EpiOut, pg8::StaticOrder, false, true>(lds, g, S, E);
    }
#endif
    GRID_BAR();

#ifndef NO_P3B
    {
        for (int m = gw; m < M; m += NGW) {
            const int b = m >> 12; const float* mb = mod + (size_t)b * 6144;
            const f32x4* xr = (const f32x4*)(X1 + (size_t)m * D) + lane;
            const float rs = 1.0f / sqrtf(ssq2[m] * (1.f / D) + EPS);
            unsigned long long* o8 = (unsigned long long*)(XN + (size_t)m * D) + lane;
#pragma unroll
            for (int j = 0; j < 4; ++j) { const int col = 4 * lane + 256 * j;
                const f32x4 sh = *(const f32x4*)(mb + 3072 + col), scl = *(const f32x4*)(mb + 4096 + col);
                const f32x4 hv = xr[64 * j] * rs * (scl + 1.0f) + sh;
                o8[64 * j] = (unsigned long long)pk2(hv.x, hv.y) | ((unsigned long long)pk2(hv.z, hv.w) << 32); }
        }
    }
#endif
    GRID_BAR();

#ifndef NO_P4
    {
        pg8::Gemm g{XN, W1_t, M, FF, D}; pg8::StaticOrder S; S.init(M, FF, G, bx);
        pg8::EpiRelu2 E{HB, FF};
        pg8::gemm_phase<pg8::EpiRelu2, pg8::StaticOrder, true, true>(lds, g, S, E);
    }
#endif
    GRID_BAR();

#ifndef NO_P5
    {
        pg8::Gemm g{HB, W2_t, M, D, FF}; pg8::StaticOrder S; S.init(M, D, G, bx);
        pg8::EpiFinal E{X1, args.out, mod + 5120};
        pg8::gemm_phase<pg8::EpiFinal, pg8::StaticOrder, false, true>(lds, g, S, E);
    }
#endif
}

extern "C" void kernel_launch(void* const* d_in, const int* in_sizes, int n_in, void* d_out, int out_size, void* d_ws, size_t ws_size, hipStream_t stream) {
    static int grid = 0;
    if (grid == 0) {
        if (n_in != 15 || out_size != M * D || ws_size < WS_END) { fprintf(stderr, "kernel_launch: unexpected problem (n_in %d out %d ws %zu)\n", n_in, out_size, ws_size); grid = -1; return; }
        int dev = 0, cus = 0, per_cu = 0;
        hipGetDevice(&dev); hipDeviceGetAttribute(&cus, hipDeviceAttributeMultiprocessorCount, dev);
        if (hipFuncSetAttribute((const void*)fwd_mega, hipFuncAttributeMaxDynamicSharedMemorySize, LDS_BYTES) != hipSuccess) { fprintf(stderr, "kernel_launch: hipFuncSetAttribute failed\n"); grid = -1; return; }
        if (hipOccupancyMaxActiveBlocksPerMultiprocessor(&per_cu, (const void*)fwd_mega, NWAVES * 64, LDS_BYTES) != hipSuccess || per_cu < 1) { fprintf(stderr, "kernel_launch: occupancy query says %d\n", per_cu); per_cu = 1; }
        (void)hipGetLastError();
        grid = cus * per_cu;
        fprintf(stderr, "kernel_launch: grid %d (cus %d per_cu %d)\n", grid, cus, per_cu);
    }
    if (grid < 0) return;
    hipMemsetAsync((char*)d_ws + WS_CTL, 0, CTL_ZERO_BYTES, stream);
    Args a{};
    for (int i = 0; i < 15; ++i) a.in[i] = (const float*)d_in[i];
    a.out = (float*)d_out; a.ws = (unsigned char*)d_ws;
    for (int j = 0; j < 8; ++j) a.invf[j] = powf(500000.0f, -(float)(2 * j) / 16.0f);
    void* kargs[] = {&a};
    hipError_t e = hipLaunchCooperativeKernel((const void*)fwd_mega, dim3(grid), dim3(NWAVES * 64), kargs, LDS_BYTES, stream);
    if (e != hipSuccess) fprintf(stderr, "kernel_launch: cooperative launch failed: %s (grid %d)\n", hipGetErrorString(e), grid);
}
```

```cpp
#include <hip/hip_runtime.h>
#include <hip/hip_cooperative_groups.h>
#include <cstdio>
#include <cstdint>
#include <cmath>
namespace pg8 {
#define PG8_LAS __attribute__((address_space(3)))
typedef unsigned short bf16_t;
typedef short bf16x8 __attribute__((ext_vector_type(8)));
typedef float f32x4 __attribute__((ext_vector_type(4)));
typedef unsigned u32x4 __attribute__((ext_vector_type(4)));
constexpr int BM = 256, BK = 64, HALF = 128, HTB = HALF * BK * 2  , STAGE_BYTES = 8 * HTB, NXCD = 8, WGM = 8;

__host__ __device__ __forceinline__ int lds_byte(int r, int c) { const int st = (r >> 4) * 2 + (c >> 5), rr = r & 15, cc = c & 31, ob = rr * 64 + cc * 2; return st * 1024 + (ob ^ (((ob >> 9) & 1) << 5)); }
__host__ __device__ __forceinline__ void stage_rc(int b, int& R, int& C) { const int st = b / 1024, sb = b % 1024, swz = sb ^ (((sb >> 9) & 1) << 5); R = (st >> 1) * 16 + swz / 64; C = (st & 1) * 32 + (swz % 64) / 2; }
__host__ __device__ __forceinline__ int perm32(int rho) { const int n = rho >> 4, i = rho & 15; return 8 * (i >> 2) + 4 * n + (i & 3); }

struct Unit { int pm, pn; };
struct Gemm { const bf16_t* A; const bf16_t* Bt; int M, N, K; };

struct StaticOrder {
    int nM, nN, nwg, G, c;
    __host__ __device__ void init(int M, int N, int G_, int c_) { nM = M / BM; nN = N / BM; nwg = nM * nN; G = G_; c = c_; }
    __host__ __device__ bool next(int i, Unit& u) const {
        const long L = (long)i * G + c; if (L >= nwg) return false;
        int wgid = (int)L; { const int q = nwg / NXCD, r = nwg % NXCD, xcd = wgid % NXCD, off = wgid / NXCD; wgid = (xcd < r ? xcd * (q + 1) : r * (q + 1) + (xcd - r) * q) + off; }
        const int nig = WGM * nN, gid = wgid / nig, fm = gid * WGM, gsz = (nM - fm) < WGM ? (nM - fm) : WGM;
        u.pm = fm + ((wgid % nig) % gsz); u.pn = (wgid % nig) / gsz; return true;
    }
    __device__ __forceinline__ void a_ready(const Unit&) const {}
    __device__ __forceinline__ void done(const Unit&) const {}
};

__device__ __forceinline__ unsigned cvt_pk_bf16(float lo, float hi) { unsigned r; asm volatile("v_cvt_pk_bf16_f32 %0, %1, %2" : "=v"(r) : "v"(lo), "v"(hi)); return r; }
typedef float f32x2 __attribute__((ext_vector_type(2)));

constexpr float kEPS = 1e-6f;
constexpr float kQSCALE = 0.125f * 1.4426950408889634f;
#define PG8_LWAIT() asm volatile("s_waitcnt lgkmcnt(0)" ::: "memory")

struct EpiQKV {
    static constexpr bool PERM = true, AFTER_DRAIN = false, HAS_MID = false;
    bf16_t* O; const float* gains; const float* rope; PG8_LAS float* xch;
    __device__ __forceinline__ void operator()(f32x4 (&acc)[2][2][4][2], const Unit& u, int wr, int wc, int fr_in, int fq_in) const {
        int fr = fr_in, fq = fq_in; asm volatile("" : "+v"(fr), "+v"(fq));
        const int seg = u.pn >> 1;
        const int row0 = u.pm * BM + wr * 64 + fr, col0 = u.pn * BM + wc * 32 + 8 * fq;
        const bool normed = (seg != 2) && (seg != 5);
        if (normed) {
#pragma unroll
            for (int ai = 0; ai < 2; ++ai)
#pragma unroll
                for (int m = 0; m < 4; ++m)
#pragma unroll
                    for (int bj = 0; bj < 2; ++bj) {
                        const f32x4 a = acc[ai][bj][m][0], b = acc[ai][bj][m][1];
                        float s = (a[0] * a[0] + a[1] * a[1]) + (a[2] * a[2] + a[3] * a[3]) + (b[0] * b[0] + b[1] * b[1]) + (b[2] * b[2] + b[3] * b[3]);
                        s += __shfl_xor(s, 16); s += __shfl_xor(s, 32);
                        if (fq == 0) xch[(ai * HALF + wr * 64 + m * 16 + fr) * 8 + (2 * bj + (wc >> 1)) * 2 + (wc & 1)] = s;
                    }
            PG8_LWAIT(); __builtin_amdgcn_s_barrier(); asm volatile("" ::: "memory");
            const float* gp = gains + 64 * ((seg == 0) ? 0 : (seg == 1) ? 1 : (seg == 3) ? 2 : 3);
            const int d0 = 32 * (wc & 1) + 8 * fq;
            const f32x4 g0 = *(const f32x4*)(gp + d0), g1 = *(const f32x4*)(gp + d0 + 4);
            const float qs = (seg == 0 || seg == 3) ? kQSCALE : 1.f;
            const bool do_rope = (seg < 2) && ((wc & 1) == 0);
#pragma unroll
            for (int ai = 0; ai < 2; ++ai)
#pragma unroll
                for (int m = 0; m < 4; ++m) {
                    const int rl = ai * HALF + wr * 64 + m * 16 + fr;
                    f32x4 c0 = {1.f, 1.f, 1.f, 1.f}, c1 = c0, s0 = {0.f, 0.f, 0.f, 0.f}, s1 = s0;
                    if (do_rope) {
                        const int t = (u.pm * BM + rl) & 4095;
                        const f32x4* rp = (const f32x4*)(rope + (size_t)t * 16);
                        c0 = rp[0]; c1 = rp[1]; s0 = rp[2]; s1 = rp[3];
                    }
#pragma unroll
                    for (int bj = 0; bj < 2; ++bj) {
                        const PG8_LAS float* xp = xch + rl * 8 + (2 * bj + (wc >> 1)) * 2;
                        const float rsq = __builtin_amdgcn_rsqf((xp[0] + xp[1]) * (1.0f / 64.0f) + kEPS);
                        f32x4 v0 = acc[ai][bj][m][0] * rsq * g0, v1 = acc[ai][bj][m][1] * rsq * g1;
                        if (do_rope) {
                            f32x4 p0, p1;
#pragma unroll
                            for (int e = 0; e < 4; ++e) { p0[e] = __shfl_xor(v0[e], 16); p1[e] = __shfl_xor(v1[e], 16); }
                            const float sg = (fq == 0) ? -1.f : 1.f;
                            if (fq < 2) { v0 = v0 * c0 + p0 * s0 * sg; v1 = v1 * c1 + p1 * s1 * sg; }
                        }
                        v0 = v0 * qs; v1 = v1 * qs;
                        u32x4 w; w.x = cvt_pk_bf16(v0[0], v0[1]); w.y = cvt_pk_bf16(v0[2], v0[3]); w.z = cvt_pk_bf16(v1[0], v1[1]); w.w = cvt_pk_bf16(v1[2], v1[3]);
                        *(u32x4*)(O + (size_t)(row0 + ai * HALF + m * 16) * 3072 + col0 + bj * HALF) = w;
                    }
                    asm volatile("" ::: "memory");
                }
        } else {
#pragma unroll
            for (int ai = 0; ai < 2; ++ai)
#pragma unroll
                for (int m = 0; m < 4; ++m)
#pragma unroll
                    for (int bj = 0; bj < 2; ++bj) {
                        const f32x4 v0 = acc[ai][bj][m][0], v1 = acc[ai][bj][m][1];
                        u32x4 w; w.x = cvt_pk_bf16(v0[0], v0[1]); w.y = cvt_pk_bf16(v0[2], v0[3]); w.z = cvt_pk_bf16(v1[0], v1[1]); w.w = cvt_pk_bf16(v1[2], v1[3]);
                        *(u32x4*)(O + (size_t)(row0 + ai * HALF + m * 16) * 3072 + col0 + bj * HALF) = w;
                    }
        }
    }
};

struct EpiRelu2 {
    static constexpr bool PERM = true, AFTER_DRAIN = false, HAS_MID = false;
    bf16_t* O; int ldc;
    __device__ __forceinline__ void operator()(f32x4 (&acc)[2][2][4][2], const Unit& u, int wr, int wc, int fr_in, int fq_in) const {
        int fr = fr_in, fq = fq_in; asm volatile("" : "+v"(fr), "+v"(fq));
        const int row0 = u.pm * BM + wr * 64 + fr, col0 = u.pn * BM + wc * 32 + 8 * fq;
#pragma unroll
        for (int ai = 0; ai < 2; ++ai)
#pragma unroll
            for (int m = 0; m < 4; ++m)
#pragma unroll
                for (int bj = 0; bj < 2; ++bj) {
                    f32x4 v0 = acc[ai][bj][m][0], v1 = acc[ai][bj][m][1];
#pragma unroll
                    for (int e = 0; e < 4; ++e) { const float a = fmaxf(v0[e], 0.f), b = fmaxf(v1[e], 0.f); v0[e] = a * a; v1[e] = b * b; }
                    u32x4 w; w.x = cvt_pk_bf16(v0[0], v0[1]); w.y = cvt_pk_bf16(v0[2], v0[3]); w.z = cvt_pk_bf16(v1[0], v1[1]); w.w = cvt_pk_bf16(v1[2], v1[3]);
                    *(u32x4*)(O + (size_t)(row0 + ai * HALF + m * 16) * ldc + col0 + bj * HALF) = w;
                }
    }
};

struct EpiOut {
    static constexpr bool PERM = false, AFTER_DRAIN = false, HAS_MID = true;
    const float* x; float* x1; const float* ga; float* ssq2; const PG8_LAS float* tab;
    __device__ __forceinline__ void mid(f32x4 (&acc)[2][2][4][2], int wr, int fr_in) const {
        int fr = fr_in; asm volatile("" : "+v"(fr));
#pragma unroll
        for (int ai = 0; ai < 2; ++ai)
#pragma unroll
            for (int m = 0; m < 4; ++m) { const float r = tab[ai * HALF + wr * 64 + m * 16 + fr];
#pragma unroll
                for (int bj = 0; bj < 2; ++bj) { acc[ai][bj][m][0] *= r; acc[ai][bj][m][1] *= r; } }
    }
    __device__ __forceinline__ void operator()(f32x4 (&acc)[2][2][4][2], const Unit& u, int wr, int wc, int fr_in, int fq_in) const {
        int fr = fr_in, fq = fq_in; asm volatile("" : "+v"(fr), "+v"(fq));
        const int col0 = u.pn * BM + wc * 32 + 4 * fq; const float* gab = ga + (size_t)(u.pm >> 4) * 6144;
        f32x4 gv[2][2];
#pragma unroll
        for (int bj = 0; bj < 2; ++bj)
#pragma unroll
            for (int n = 0; n < 2; ++n) gv[bj][n] = *(const f32x4*)(gab + col0 + bj * HALF + n * 16);
#pragma unroll
        for (int ai = 0; ai < 2; ++ai)
#pragma unroll
            for (int m = 0; m < 4; ++m) { const int rl = ai * HALF + wr * 64 + m * 16 + fr; const float rf = tab[256 + rl]; const size_t off = (size_t)(u.pm * BM + rl) * 1024 + col0; float s = 0.f;
#pragma unroll
                for (int bj = 0; bj < 2; ++bj)
#pragma unroll
                    for (int n = 0; n < 2; ++n) { const f32x4 xs = *(const f32x4*)(x + off + bj * HALF + n * 16); const f32x4 o = xs + gv[bj][n] * (acc[ai][bj][m][n] * rf);
                        s += (o[0] * o[0] + o[1] * o[1]) + (o[2] * o[2] + o[3] * o[3]); *(f32x4*)(x1 + off + bj * HALF + n * 16) = o; }
                s += __shfl_xor(s, 16); s += __shfl_xor(s, 32);
                if (fq == 0) atomicAdd(ssq2 + u.pm * BM + rl, s);
                asm volatile("" ::: "memory"); }
    }
};

struct EpiFinal {
    static constexpr bool PERM = false, AFTER_DRAIN = false, HAS_MID = false;
    const float* x1; float* out; const float* gm;
    __device__ __forceinline__ void operator()(f32x4 (&acc)[2][2][4][2], const Unit& u, int wr, int wc, int fr_in, int fq_in) const {
        int fr = fr_in, fq = fq_in; asm volatile("" : "+v"(fr), "+v"(fq));
        const int col0 = u.pn * BM + wc * 32 + 4 * fq; const float* gmb = gm + (size_t)(u.pm >> 4) * 6144;
        f32x4 gv[2][2];
#pragma unroll
        for (int bj = 0; bj < 2; ++bj)
#pragma unroll
            for (int n = 0; n < 2; ++n) gv[bj][n] = *(const f32x4*)(gmb + col0 + bj * HALF + n * 16);
#pragma unroll
        for (int ai = 0; ai < 2; ++ai)
#pragma unroll
            for (int m = 0; m < 4; ++m) { const size_t off = (size_t)(u.pm * BM + ai * HALF + wr * 64 + m * 16 + fr) * 1024 + col0;
#pragma unroll
                for (int bj = 0; bj < 2; ++bj)
#pragma unroll
                    for (int n = 0; n < 2; ++n) { const f32x4 xs = *(const f32x4*)(x1 + off + bj * HALF + n * 16); *(f32x4*)(out + off + bj * HALF + n * 16) = xs + gv[bj][n] * acc[ai][bj][m][n]; }
                asm volatile("" ::: "memory"); }
    }
};
template <class Epi, class Sched, bool ALIGN_EPI = false, bool SP2 = false>
__device__ __forceinline__ void gemm_phase(PG8_LAS unsigned char* lds, const Gemm g, const Sched& S, const Epi& E) {
    const int tid = threadIdx.x, wid = __builtin_amdgcn_readfirstlane(tid >> 6), lane = tid & 63, wr = wid >> 2, wc = wid & 3, fr = lane & 15, fq = lane >> 4;
    const int K = g.K, nt = K / BK;
    unsigned voffA[2], voffB[2];
#pragma unroll
    for (int i = 0; i < 2; ++i) { int R, C; stage_rc(tid * 16 + i * 8192, R, C); const int Rb = Epi::PERM ? ((R & ~31) + perm32(R & 31)) : R;
        voffA[i] = (unsigned)(R * K + C) * 2u; voffB[i] = (unsigned)(Rb * K + C) * 2u; }
    const size_t kstep = (size_t)(BK * 2);
    const size_t hstep = (size_t)HALF * K * 2;
    const size_t tstep = 2 * hstep;
    const unsigned ldsw = (unsigned)wid * 1024u;
    const int aoff = lds_byte(wr * 64 + fr, fq * 8), boff = lds_byte(wc * 32 + fr, fq * 8);
#define PG8_SA(b, h) (((b) * 2 + (h)) * HTB)
#define PG8_SB(b, h) ((4 + (b) * 2 + (h)) * HTB)
#define PG8_STAGE(bufoff, gbase, voff) do { _Pragma("unroll") for (int _i = 0; _i < 2; ++_i) \
        __builtin_amdgcn_global_load_lds((const unsigned*)((const char*)(gbase) + (voff)[_i]), (PG8_LAS unsigned*)(lds + (bufoff) + ldsw + _i * 8192), 16, 0, 0); } while (0)
#define PG8_LDA(dst, b, h) do { _Pragma("unroll") for (int m = 0; m < 4; ++m) _Pragma("unroll") for (int k = 0; k < 2; ++k) dst[m][k] = *(const PG8_LAS bf16x8*)(lds + PG8_SA(b, h) + aoff + m * 2048 + k * 1024); } while (0)
#define PG8_LDB(dst, b, h) do { _Pragma("unroll") for (int n = 0; n < 2; ++n) _Pragma("unroll") for (int k = 0; k < 2; ++k) dst[n][k] = *(const PG8_LAS bf16x8*)(lds + PG8_SB(b, h) + boff + n * 2048 + k * 1024); } while (0)
#define PG8_MMA(ai, bj, At, Bt) do { __builtin_amdgcn_s_setprio(1); _Pragma("unroll") for (int m = 0; m < 4; ++m) _Pragma("unroll") for (int n = 0; n < 2; ++n) _Pragma("unroll") for (int k = 0; k < 2; ++k) \
        acc[ai][bj][m][n] = __builtin_amdgcn_mfma_f32_16x16x32_bf16(Bt[n][k], At[m][k], acc[ai][bj][m][n], 0, 0, 0); __builtin_amdgcn_s_setprio(0); } while (0)
#define PG8_WAIT_V(n) asm volatile("s_waitcnt vmcnt(" #n ")" ::: "memory")
#define PG8_WAIT_L(n) asm volatile("s_waitcnt lgkmcnt(" #n ")" ::: "memory")
#define PG8_BAR __builtin_amdgcn_s_barrier()
#define PG8_SCHED __builtin_amdgcn_sched_barrier(0)
    Unit cur, nxt; int ui = 0;
    if (!S.next(0, cur)) return;
    f32x4 acc[2][2][4][2];
#pragma unroll
    for (int a = 0; a < 2; ++a)
#pragma unroll
        for (int b = 0; b < 2; ++b)
#pragma unroll
            for (int m = 0; m < 4; ++m)
#pragma unroll
                for (int n = 0; n < 2; ++n) acc[a][b][m][n] = (f32x4){0.f, 0.f, 0.f, 0.f};
    bf16x8 At[4][2], B0[2][2], B1[2][2];
    const char* cA = (const char*)g.A + (size_t)cur.pm * tstep; const char* cB = (const char*)g.Bt + (size_t)cur.pn * tstep;
    S.a_ready(cur);
    if constexpr (SP2) {
        PG8_STAGE(PG8_SB(0, 0), cB, voffB); PG8_STAGE(PG8_SB(0, 1), cB + hstep, voffB); PG8_STAGE(PG8_SA(0, 0), cA, voffA); PG8_STAGE(PG8_SA(0, 1), cA + hstep, voffA);
        if (wr == 1) PG8_BAR;
        PG8_WAIT_V(2); PG8_BAR;
        PG8_STAGE(PG8_SB(1, 0), cB + kstep, voffB); PG8_STAGE(PG8_SA(1, 0), cA + kstep, voffA); PG8_STAGE(PG8_SB(1, 1), cB + hstep + kstep, voffB);
        PG8_WAIT_V(6); PG8_BAR;
    } else {
        PG8_STAGE(PG8_SB(0, 0), cB, voffB); PG8_STAGE(PG8_SA(0, 0), cA, voffA); PG8_STAGE(PG8_SB(0, 1), cB + hstep, voffB); PG8_STAGE(PG8_SA(0, 1), cA + hstep, voffA);
        if (wr == 1) PG8_BAR;
        PG8_WAIT_V(4); PG8_BAR;
        PG8_STAGE(PG8_SB(1, 0), cB + kstep, voffB); PG8_STAGE(PG8_SA(1, 0), cA + kstep, voffA); PG8_STAGE(PG8_SB(1, 1), cB + hstep + kstep, voffB);
        PG8_WAIT_V(6); PG8_BAR;
    }
    for (;;) {
        const bool has_next = S.next(ui + 1, nxt);
        const char* nA = has_next ? (const char*)g.A + (size_t)nxt.pm * tstep : cA; const char* nB = has_next ? (const char*)g.Bt + (size_t)nxt.pn * tstep : cB;
        for (int t = 0; t < nt; t += 2) {
            if constexpr (Epi::HAS_MID) { if (t == (nt >> 1)) E.mid(acc, wr, fr); }
            const bool last = (t == nt - 2);
            const char* a1 = cA + (size_t)(t + 1) * kstep;
            const char* a2 = last ? nA : cA + (size_t)(t + 2) * kstep; const char* b2 = last ? nB : cB + (size_t)(t + 2) * kstep;
            const char* a3 = a2 + kstep; const char* b3 = b2 + kstep;
            if (last && has_next) S.a_ready(nxt);
            if constexpr (SP2) {
            PG8_LDB(B0, 0, 0); PG8_LDB(B1, 0, 1); PG8_SCHED; PG8_LDA(At, 0, 0); PG8_STAGE(PG8_SA(1, 1), a1 + hstep, voffA);
            PG8_WAIT_V(8); PG8_WAIT_L(0); PG8_BAR; PG8_MMA(0, 0, At, B0); PG8_MMA(0, 1, At, B1); PG8_BAR; PG8_SCHED;
            PG8_LDA(At, 0, 1); PG8_STAGE(PG8_SB(0, 0), b2, voffB); PG8_STAGE(PG8_SB(0, 1), b2 + hstep, voffB); PG8_STAGE(PG8_SA(0, 0), a2, voffA);
            PG8_WAIT_V(8); PG8_WAIT_L(0); PG8_BAR; PG8_MMA(1, 0, At, B0); PG8_MMA(1, 1, At, B1); PG8_BAR; PG8_SCHED;
            PG8_LDB(B0, 1, 0); PG8_LDB(B1, 1, 1); PG8_SCHED; PG8_LDA(At, 1, 0); PG8_STAGE(PG8_SA(0, 1), a2 + hstep, voffA);
            PG8_WAIT_V(8); PG8_WAIT_L(0); PG8_BAR; PG8_MMA(0, 0, At, B0); PG8_MMA(0, 1, At, B1); PG8_BAR; PG8_SCHED;
            PG8_LDA(At, 1, 1); PG8_STAGE(PG8_SB(1, 0), b3, voffB); PG8_STAGE(PG8_SB(1, 1), b3 + hstep, voffB); PG8_STAGE(PG8_SA(1, 0), a3, voffA);
            PG8_WAIT_V(8); PG8_WAIT_L(0); PG8_BAR; PG8_MMA(1, 0, At, B0); PG8_MMA(1, 1, At, B1); PG8_BAR; PG8_SCHED;
            } else {
            PG8_LDB(B0, 0, 0); PG8_SCHED; PG8_LDA(At, 0, 0); PG8_STAGE(PG8_SA(1, 1), a1 + hstep, voffA);
            PG8_WAIT_L(8); PG8_BAR; PG8_WAIT_L(0); PG8_MMA(0, 0, At, B0); PG8_BAR; PG8_SCHED;
            PG8_LDB(B1, 0, 1); PG8_STAGE(PG8_SB(0, 0), b2, voffB);
            PG8_BAR; PG8_WAIT_L(0); PG8_MMA(0, 1, At, B1); PG8_BAR;
            PG8_LDA(At, 0, 1); PG8_STAGE(PG8_SA(0, 0), a2, voffA);
            PG8_BAR; PG8_WAIT_L(0); PG8_MMA(1, 0, At, B0); PG8_BAR; PG8_SCHED;
            PG8_STAGE(PG8_SB(0, 1), b2 + hstep, voffB);
            PG8_WAIT_V(6); PG8_BAR; PG8_MMA(1, 1, At, B1); PG8_BAR;
            PG8_LDB(B0, 1, 0); PG8_SCHED; PG8_LDA(At, 1, 0); PG8_STAGE(PG8_SA(0, 1), a2 + hstep, voffA);
            PG8_WAIT_L(8); PG8_BAR; PG8_WAIT_L(0); PG8_MMA(0, 0, At, B0); PG8_BAR; PG8_SCHED;
            PG8_LDB(B1, 1, 1); PG8_STAGE(PG8_SB(1, 0), b3, voffB);
            PG8_BAR; PG8_WAIT_L(0); PG8_MMA(0, 1, At, B1); PG8_BAR;
            PG8_LDA(At, 1, 1); PG8_STAGE(PG8_SA(1, 0), a3, voffA);
            PG8_BAR; PG8_WAIT_L(0); PG8_MMA(1, 0, At, B0); PG8_BAR; PG8_SCHED;
            PG8_STAGE(PG8_SB(1, 1), b3 + hstep, voffB);
            PG8_WAIT_V(6); PG8_BAR; PG8_MMA(1, 1, At, B1); PG8_BAR;
            }
        }
        if constexpr (ALIGN_EPI) { if (wr == 0) PG8_BAR; }
        if constexpr (!Epi::AFTER_DRAIN) { E(acc, cur, wr, wc, fr, fq); S.done(cur); }
        if (!has_next) break;
#pragma unroll
        for (int a = 0; a < 2; ++a)
#pragma unroll
            for (int b = 0; b < 2; ++b)
#pragma unroll
                for (int m = 0; m < 4; ++m)
#pragma unroll
                    for (int n = 0; n < 2; ++n) acc[a][b][m][n] = (f32x4){0.f, 0.f, 0.f, 0.f};
        cur = nxt; cA = nA; cB = nB; ++ui;
        if constexpr (ALIGN_EPI) { if (wr == 1) PG8_BAR; }
    }
    PG8_WAIT_V(0);
    if constexpr (!ALIGN_EPI) { if (wr == 0) PG8_BAR; }
    PG8_BAR;
    if constexpr (Epi::AFTER_DRAIN) { E.fused(acc, cur, wr, wc, fr, fq, lds, wid, lane); S.done(cur); }
#undef PG8_SA
#undef PG8_SB
#undef PG8_STAGE
#undef PG8_LDA
#undef PG8_LDB
#undef PG8_MMA
#undef PG8_WAIT_V
#undef PG8_WAIT_L
#undef PG8_BAR
#undef PG8_SCHED
}
}

namespace att {
#define ATT_LAS __attribute__((address_space(3)))
typedef unsigned short bf16_t;
typedef short bf16x8 __attribute__((ext_vector_type(8)));
typedef short s16x4 __attribute__((ext_vector_type(4)));
typedef float f32x16 __attribute__((ext_vector_type(16)));
typedef float f32x4 __attribute__((ext_vector_type(4)));
typedef unsigned u32x4 __attribute__((ext_vector_type(4)));
constexpr int SEQ = 4096, NQKV = 3072;
constexpr int ROWB = 144;
constexpr int TILEB = 64 * ROWB;
constexpr int L_K = 0, L_V = 2 * TILEB, L_CK = 4 * TILEB, L_KMH = L_CK + 512, L_KML = L_KMH + 32 * ROWB, L_WS = L_KML + 32 * ROWB, L_T0 = L_WS + 8 * 256, L_END = L_T0 + 64;
constexpr float NEG = -1.0e30f;
__device__ __forceinline__ unsigned cvtpk(float lo, float hi) { unsigned r; asm volatile("v_cvt_pk_bf16_f32 %0, %1, %2" : "=v"(r) : "v"(lo), "v"(hi)); return r; }
__device__ __forceinline__ s16x4 vtr(const ATT_LAS unsigned char* p) { return __builtin_bit_cast(s16x4, __builtin_amdgcn_ds_read_tr16_b64_v4i16((ATT_LAS s16x4*)p)); }
__device__ __forceinline__ unsigned f2bf(float f) { unsigned u = __builtin_bit_cast(unsigned, f); return (u + 0x7fffu + ((u >> 16) & 1u)) >> 16; }

template <bool FOX>
__device__ __forceinline__ void attn_unit(int b, int h, int qb, const bf16_t* __restrict__ QKV, const float* __restrict__ cl, const float* __restrict__ kmean,
                                          bf16_t* __restrict__ O, float* __restrict__ ssq, ATT_LAS unsigned char* lds, float fox_thr) {
    const int tid = threadIdx.x, lane = tid & 63, r32 = lane & 31, hi = lane >> 5;
    const int wid = __builtin_amdgcn_readfirstlane(tid >> 6);
    const int qcol = FOX ? 1536 + h * 64 : h * 64, kcol = qcol + 512, vcol = qcol + 1024, ocol = FOX ? 512 + h * 64 : h * 64;
    const size_t rowbase = (size_t)b * SEQ; const int q0 = qb * 256;
    const int qpos = q0 + wid * 32 + r32;
    bf16x8 qr[4];
    { const bf16_t* qp = QKV + (rowbase + qpos) * NQKV + qcol + hi * 8;
#pragma unroll
      for (int d0 = 0; d0 < 4; ++d0) qr[d0] = *(const bf16x8*)(qp + d0 * 16); }
    const int lrow = tid >> 3, lch = tid & 7;
    const bf16_t* __restrict__ ksrc = QKV + (rowbase + lrow) * NQKV + kcol + lch * 8;
    const bf16_t* __restrict__ vsrc = QKV + (rowbase + lrow) * NQKV + vcol + lch * 8;
    const int ldst = lrow * ROWB + lch * 16;
    const float* clh = cl + (size_t)(b * 8 + h) * SEQ;
    float cq = 0.f; if (FOX) cq = clh[qpos];
    unsigned sel = 0xffffffffu;
    ATT_LAS float* wsf = (ATT_LAS float*)(lds + L_WS) + wid * 64;
    if (!FOX) {
        { const float* km = kmean + (size_t)(b * 8 + h) * 1024;
          const int i0 = tid * 2, n = i0 >> 6, d = i0 & 63;
          const float v0 = km[i0], v1 = km[i0 + 1];
          const unsigned h0 = f2bf(v0), h1 = f2bf(v1);
          const float r0 = v0 - __uint_as_float(h0 << 16), r1 = v1 - __uint_as_float(h1 << 16);
          *(ATT_LAS unsigned*)(lds + L_KMH + n * ROWB + d * 2) = h0 | (h1 << 16);
          *(ATT_LAS unsigned*)(lds + L_KML + n * ROWB + d * 2) = f2bf(r0) | (f2bf(r1) << 16);
          *(ATT_LAS unsigned*)(lds + L_KMH + (16 + n) * ROWB + d * 2) = 0u;
          *(ATT_LAS unsigned*)(lds + L_KML + (16 + n) * ROWB + d * 2) = 0u; }
        __syncthreads();
        f32x16 g = {};
#pragma unroll
        for (int d0 = 0; d0 < 4; ++d0) {
            const bf16x8 kh = *(const ATT_LAS bf16x8*)(lds + L_KMH + r32 * ROWB + (d0 * 16 + hi * 8) * 2);
            const bf16x8 kl = *(const ATT_LAS bf16x8*)(lds + L_KML + r32 * ROWB + (d0 * 16 + hi * 8) * 2);
            g = __builtin_amdgcn_mfma_f32_32x32x16_bf16(kh, qr[d0], g, 0, 0, 0);
            g = __builtin_amdgcn_mfma_f32_32x32x16_bf16(kl, qr[d0], g, 0, 0, 0);
        }
        float G[16];
#pragma unroll
        for (int n = 0; n < 16; ++n) { const int r = (n & 3) + 4 * (n >> 3); const float mine = g[r], oth = __shfl_xor(g[r], 32); G[n] = (((n >> 2) & 1) == hi) ? mine : oth; }
        sel = 0u;
#pragma unroll
        for (int pass = 0; pass < 3; ++pass) {
            float best = -INFINITY; int bi = -1;
#pragma unroll
            for (int n = 0; n < 16; ++n) { const bool ok = (n < qb) && (((sel >> n) & 1u) == 0u) && (G[n] > best); if (ok) { best = G[n]; bi = n; } }
            if (bi >= 0) sel |= (1u << bi);
        }
    }
    const int NT = 4 * (qb + 1);
    int T0 = 0;
    if (FOX) {
        if (wid == 0) { const float c0 = clh[q0]; const bool ok = (lane < NT) && (c0 - clh[64 * (lane < NT ? lane : 0) + 63] >= -fox_thr);
            const unsigned long long bal = __ballot(ok ? 1 : 0); if (lane == 0) *(ATT_LAS int*)(lds + L_T0) = bal ? (__ffsll((long long)bal) - 1) : (NT - 1); }
        __syncthreads();
        T0 = *(const ATT_LAS int*)(lds + L_T0);
        ksrc += (size_t)T0 * 64 * NQKV; vsrc += (size_t)T0 * 64 * NQKV;
    }
    u32x4 kreg = *(const u32x4*)ksrc, vreg = *(const u32x4*)vsrc; float ckr = 0.f;
    if (FOX && tid < 64) ckr = clh[T0 * 64 + tid];
    *(ATT_LAS u32x4*)(lds + L_K + ldst) = kreg; *(ATT_LAS u32x4*)(lds + L_V + ldst) = vreg;
    if (FOX && tid < 64) *(ATT_LAS float*)(lds + L_CK + tid * 4) = ckr;
    __syncthreads();
    float m_run = NEG, l_run = 0.f; f32x16 o0 = {}, o1 = {};
    const int vrow = 4 * hi + ((lane & 15) >> 2), vcb = (16 * ((lane >> 4) & 1) + 4 * (lane & 3)) * 2;
    for (int t = T0; t < NT; ++t) {
        const int buf = (t - T0) & 1;
        if (t + 1 < NT) {
            kreg = *(const u32x4*)(ksrc + (size_t)(t + 1 - T0) * 64 * NQKV); vreg = *(const u32x4*)(vsrc + (size_t)(t + 1 - T0) * 64 * NQKV);
            if (FOX && tid < 64) ckr = clh[(t + 1) * 64 + tid];
        }
        const int blk = t >> 2, jb = t & 3; const bool diag = (blk == qb);
        bool act = !(diag && (64 * jb > 32 * wid + 31));
        bool allowed = true;
        if (!FOX && !diag) { allowed = ((sel >> blk) & 1u) != 0u; act = act && (__any(allowed ? 1 : 0) != 0); }
        if (act) {
            const ATT_LAS unsigned char* Kb = lds + L_K + buf * TILEB; const ATT_LAS unsigned char* Vb = lds + L_V + buf * TILEB;
            f32x16 p0, p1;
            if (FOX) {
                const ATT_LAS float* ck = (const ATT_LAS float*)(lds + L_CK + buf * 256);
#pragma unroll
                for (int gq = 0; gq < 4; ++gq) { const f32x4 c0 = *(const ATT_LAS f32x4*)(ck + 8 * gq + 4 * hi), c1 = *(const ATT_LAS f32x4*)(ck + 32 + 8 * gq + 4 * hi);
#pragma unroll
                    for (int e = 0; e < 4; ++e) { p0[4 * gq + e] = cq - c0[e]; p1[4 * gq + e] = cq - c1[e]; } }
            } else { p0 = (f32x16){}; p1 = (f32x16){}; }
#pragma unroll
            for (int d0 = 0; d0 < 4; ++d0) {
                const bf16x8 k0 = *(const ATT_LAS bf16x8*)(Kb + r32 * ROWB + (d0 * 16 + hi * 8) * 2);
                const bf16x8 k1 = *(const ATT_LAS bf16x8*)(Kb + (32 + r32) * ROWB + (d0 * 16 + hi * 8) * 2);
                p0 = __builtin_amdgcn_mfma_f32_32x32x16_bf16(k0, qr[d0], p0, 0, 0, 0);
                p1 = __builtin_amdgcn_mfma_f32_32x32x16_bf16(k1, qr[d0], p1, 0, 0, 0);
            }
            if (diag) {
                const int kv0 = jb * 64 + 4 * hi, qrel = wid * 32 + r32;
#pragma unroll
                for (int r = 0; r < 16; ++r) { const int kv = kv0 + (r & 3) + 8 * (r >> 2); if (kv > qrel) p0[r] = NEG; if (kv + 32 > qrel) p1[r] = NEG; }
            } else if (!FOX) {
                if (!allowed) {
#pragma unroll
                    for (int r = 0; r < 16; ++r) { p0[r] = NEG; p1[r] = NEG; } }
            }
            float mx = fmaxf(p0[0], p1[0]);
#pragma unroll
            for (int r = 1; r < 16; ++r) mx = fmaxf(mx, fmaxf(p0[r], p1[r]));
            mx = fmaxf(mx, __shfl_xor(mx, 32));
            const float m_new = fmaxf(m_run, mx);
            const float alpha = __builtin_amdgcn_exp2f(m_run - m_new); m_run = m_new;
            float ls = 0.f;
#pragma unroll
            for (int r = 0; r < 16; ++r) { p0[r] = __builtin_amdgcn_exp2f(p0[r] - m_new); p1[r] = __builtin_amdgcn_exp2f(p1[r] - m_new); ls += p0[r] + p1[r]; }
            l_run = l_run * alpha + ls;
            if (__any(alpha != 1.0f ? 1 : 0)) {
                if (hi == 0) wsf[r32] = alpha;
                asm volatile("s_waitcnt lgkmcnt(0)" ::: "memory");
#pragma unroll
                for (int gq = 0; gq < 4; ++gq) { const f32x4 a = *(const ATT_LAS f32x4*)(wsf + 8 * gq + 4 * hi);
#pragma unroll
                    for (int e = 0; e < 4; ++e) { o0[4 * gq + e] *= a[e]; o1[4 * gq + e] *= a[e]; } }
            }
#pragma unroll
            for (int c = 0; c < 2; ++c)
#pragma unroll
                for (int uu = 0; uu < 2; ++uu) {
                    u32x4 pw;
                    if (c == 0) { pw.x = cvtpk(p0[8 * uu + 0], p0[8 * uu + 1]); pw.y = cvtpk(p0[8 * uu + 2], p0[8 * uu + 3]); pw.z = cvtpk(p0[8 * uu + 4], p0[8 * uu + 5]); pw.w = cvtpk(p0[8 * uu + 6], p0[8 * uu + 7]); }
                    else        { pw.x = cvtpk(p1[8 * uu + 0], p1[8 * uu + 1]); pw.y = cvtpk(p1[8 * uu + 2], p1[8 * uu + 3]); pw.z = cvtpk(p1[8 * uu + 4], p1[8 * uu + 5]); pw.w = cvtpk(p1[8 * uu + 6], p1[8 * uu + 7]); }
                    const bf16x8 pa = __builtin_bit_cast(bf16x8, pw);
                    const ATT_LAS unsigned char* vp = Vb + (32 * c + 16 * uu + vrow) * ROWB + vcb;
                    const s16x4 a0 = vtr(vp), a1 = vtr(vp + 8 * ROWB), b0 = vtr(vp + 64), b1 = vtr(vp + 8 * ROWB + 64);
                    const bf16x8 vf0 = {a0[0], a0[1], a0[2], a0[3], a1[0], a1[1], a1[2], a1[3]};
                    const bf16x8 vf1 = {b0[0], b0[1], b0[2], b0[3], b1[0], b1[1], b1[2], b1[3]};
                    o0 = __builtin_amdgcn_mfma_f32_32x32x16_bf16(pa, vf0, o0, 0, 0, 0);
                    o1 = __builtin_amdgcn_mfma_f32_32x32x16_bf16(pa, vf1, o1, 0, 0, 0);
                }
        }
        if (t + 1 < NT) {
            *(ATT_LAS u32x4*)(lds + L_K + (buf ^ 1) * TILEB + ldst) = kreg; *(ATT_LAS u32x4*)(lds + L_V + (buf ^ 1) * TILEB + ldst) = vreg;
            if (FOX && tid < 64) *(ATT_LAS float*)(lds + L_CK + (buf ^ 1) * 256 + tid * 4) = ckr;
        }
        __syncthreads();
    }
    l_run += __shfl_xor(l_run, 32);
    if (hi == 0) wsf[r32] = 1.0f / l_run;
    asm volatile("s_waitcnt lgkmcnt(0)" ::: "memory");
    bf16_t* Ow = O + (rowbase + q0 + wid * 32) * 1024 + ocol + r32;
    float* sq = ssq + (FOX ? 16384 : 0) + rowbase + q0 + wid * 32;
#pragma unroll
    for (int gq = 0; gq < 4; ++gq) { const f32x4 a = *(const ATT_LAS f32x4*)(wsf + 8 * gq + 4 * hi);
#pragma unroll
        for (int e = 0; e < 4; ++e) { const int r = 4 * gq + e, row = 8 * gq + 4 * hi + e;
            const unsigned w0 = f2bf(o0[r] * a[e]), w1 = f2bf(o1[r] * a[e]);
            Ow[(size_t)row * 1024] = (bf16_t)w0; Ow[(size_t)row * 1024 + 32] = (bf16_t)w1;
            const float f0 = __uint_as_float(w0 << 16), f1 = __uint_as_float(w1 << 16);
            float s = f0 * f0 + f1 * f1;
            s += __shfl_xor(s, 1); s += __shfl_xor(s, 2); s += __shfl_xor(s, 4); s += __shfl_xor(s, 8); s += __shfl_xor(s, 16);
            if (r32 == 0) atomicAdd(sq + row, s); } }
    __syncthreads();
}
}

namespace cg = cooperative_groups;
#define LAS __attribute__((address_space(3)))
typedef unsigned short bf16;
typedef unsigned v4u __attribute__((ext_vector_type(4)));
typedef float f32x4 __attribute__((ext_vector_type(4)));
constexpr int NWAVES = 8;
constexpr int BATCH = 4, SEQ = 4096, D = 1024, M = BATCH * SEQ, NQKV = 3072, INW = 3080, FF = 4096, NHG = 8;
constexpr float EPS = 1e-6f, LOG2E = 1.4426950408889634f;
constexpr size_t MiB = 1u << 20;
constexpr size_t WS_CTL = 0, CTL_ZERO_BYTES = 1 * MiB;
constexpr size_t OFF_MOD = 64 * 1024;
constexpr size_t OFF_KMEAN = 256 * 1024;
constexpr size_t OFF_SSQO = 512 * 1024;
constexpr size_t OFF_SSQ2 = 768 * 1024;
constexpr size_t WS_GAINS = 3 * MiB;
constexpr size_t WS_ROPE = 1 * MiB;
constexpr size_t WS_LOGF = 2 * MiB;
constexpr size_t WS_CUM = WS_LOGF + 512 * 1024;
constexpr size_t WS_WIN = 4 * MiB, WS_WOUT = 10 * MiB, WS_W1 = 12 * MiB, WS_W2 = 20 * MiB;
constexpr size_t WS_XN = 32 * MiB;
constexpr size_t WS_QKV = 64 * MiB;
constexpr size_t WS_O = 160 * MiB;
constexpr size_t WS_X1 = 192 * MiB;
constexpr size_t WS_H = 64 * MiB;
constexpr size_t WS_END = 256 * MiB;
constexpr int RING_BYTES = 131072, XOFF = RING_BYTES, MISC_OFF = RING_BYTES + 24576, LDS_BYTES = MISC_OFF + 256;
constexpr int CW_QUEUE = 12288;
constexpr int CW_BAR = 4096;

__device__ __forceinline__ unsigned f2bf(float f) { unsigned u = __builtin_bit_cast(unsigned, f); return (u + 0x7fffu + ((u >> 16) & 1u)) >> 16; }
__device__ __forceinline__ unsigned pk2(float lo, float hi) { return f2bf(lo) | (f2bf(hi) << 16); }
__device__ __forceinline__ float wave_sum(float v) {
#pragma unroll
    for (int o = 1; o < 64; o <<= 1) v += __shfl_xor(v, o);
    return v;
}
__device__ __forceinline__ void transpose_item(const float* W, int ldw, int nblk, int K, bf16* WT, LAS float* scr, int item, int lane, const float* g0, const float* g1) {
    const int kb = item / nblk, nb = item % nblk, k0 = 64 * kb, n0 = 32 * nb;
#pragma unroll 8
    for (int i = 0; i < 32; ++i) { const int kk = 2 * i + (lane >> 5); float v = W[(size_t)(k0 + kk) * ldw + n0 + (lane & 31)];
        if (g0) { const int k = k0 + kk; v *= (k < 512) ? g0[k] : g1[k - 512]; }
        scr[kk * 33 + (lane & 31)] = v; }
    asm volatile("s_waitcnt lgkmcnt(0)" ::: "memory");
    const int c = lane & 7;
#pragma unroll
    for (int j = 0; j < 4; ++j) { const int n = (lane >> 3) + 8 * j; const LAS float* s = scr + (8 * c) * 33 + n;
        v4u o; o.x = pk2(s[0 * 33], s[1 * 33]); o.y = pk2(s[2 * 33], s[3 * 33]); o.z = pk2(s[4 * 33], s[5 * 33]); o.w = pk2(s[6 * 33], s[7 * 33]);
        *(v4u*)(WT + (size_t)(n0 + n) * K + k0 + 8 * c) = o; }
    asm volatile("s_waitcnt lgkmcnt(0)" ::: "memory");
}
__device__ __forceinline__ void cossin_acc(float ang, float& c, float& s) {
    double r = (double)ang; const double n = __builtin_rint(r * 0.15915494309189535); r = __builtin_fma(-n, 6.283185307179586, r);
    const double r2 = r * r;
    double ps = -1.0 / 51090942171709440000.0;
    ps = ps * r2 + 1.0 / 121645100408832000.0;
    ps = ps * r2 - 1.0 / 355687428096000.0;
    ps = ps * r2 + 1.0 / 1307674368000.0;
    ps = ps * r2 - 1.0 / 6227020800.0;
    ps = ps * r2 + 1.0 / 39916800.0;
    ps = ps * r2 - 1.0 / 362880.0;
    ps = ps * r2 + 1.0 / 5040.0;
    ps = ps * r2 - 1.0 / 120.0;
    ps = ps * r2 + 1.0 / 6.0;
    s = (float)(r - r * r2 * ps);
    double pc = 1.0 / 2432902008176640000.0;
    pc = pc * r2 - 1.0 / 6402373705728000.0;
    pc = pc * r2 + 1.0 / 20922789888000.0;
    pc = pc * r2 - 1.0 / 87178291200.0;
    pc = pc * r2 + 1.0 / 479001600.0;
    pc = pc * r2 - 1.0 / 3628800.0;
    pc = pc * r2 + 1.0 / 40320.0;
    pc = pc * r2 - 1.0 / 720.0;
    pc = pc * r2 + 1.0 / 24.0;
    pc = pc * r2 - 0.5;
    c = (float)(1.0 + r2 * pc);
}


#define XB_TMO      128
#define XB_XCNT(j)  (256  + 64 * (j))
#define XB_XSUB(j)  (1280 + 64 * (j))
#define XB_XGEN(j)  (2304 + 64 * (j))
#define XB_TOP      3328
#define XB_TOPGEN   3392
#define XCD_BAR_WORDS 3456
#define XB_SPIN_CAP (1u << 18)

__device__ __forceinline__ unsigned xb_ld(unsigned* p)              { return __hip_atomic_load(p, __ATOMIC_RELAXED, __HIP_MEMORY_SCOPE_AGENT); }
__device__ __forceinline__ unsigned xb_add(unsigned* p, unsigned v) { return __hip_atomic_fetch_add(p, v, __ATOMIC_RELAXED, __HIP_MEMORY_SCOPE_AGENT); }
__device__ __forceinline__ unsigned xb_xcc_id() { return (unsigned)__builtin_amdgcn_s_getreg((3 << 11) | 20) & 0xFu; }
#define XB_SPIN(cond, bar) do { unsigned _sp = 0; while (cond) { __builtin_amdgcn_s_sleep(1); \
    if ((++_sp & 255u) == 0u) { if (xb_ld(&(bar)[XB_TMO])) break; if (_sp > XB_SPIN_CAP) { atomicAdd(&(bar)[XB_TMO], 1u); break; } } } } while (0)

struct XcdBarrier {
    unsigned* bar; unsigned x;
    volatile LAS unsigned* st;
};

__device__ __forceinline__ XcdBarrier xcd_barrier_post(unsigned* bar, volatile LAS unsigned* st) {
    XcdBarrier b; b.bar = bar; b.x = xb_xcc_id(); b.st = st;
    if (threadIdx.x == 0) (void)xb_add(&bar[XB_XCNT(b.x)], 1u);
    return b;
}
__device__ __forceinline__ void xcd_barrier_complete(unsigned* bar, unsigned x, unsigned& nloc, unsigned& nx) {
    const unsigned G = gridDim.x * gridDim.y * gridDim.z;
    unsigned sum, cnt, mine, sp = 0u;
    for (;;) {
        sum = 0u; cnt = 0u; mine = 0u;
#pragma unroll
        for (unsigned j = 0; j < 16; ++j) { const unsigned c = xb_ld(&bar[XB_XCNT(j)]); sum += c; cnt += (c > 0u) ? 1u : 0u; mine = (j == x) ? c : mine; }
        if (sum == G) break;
        __builtin_amdgcn_s_sleep(1);
        if ((++sp & 255u) == 0u) { if (xb_ld(&bar[XB_TMO])) break; if (sp > XB_SPIN_CAP) { atomicAdd(&bar[XB_TMO], 1u); break; } }
    }
    nloc = mine > 0u ? mine : 1u; nx = cnt > 0u ? cnt : 1u;
}

__device__ __forceinline__ void xcd_barrier(const XcdBarrier& b) {
    asm volatile("s_waitcnt vmcnt(0)" ::: "memory");
    __syncthreads();
    if (threadIdx.x == 0) {
        unsigned* bar = b.bar;
        __builtin_amdgcn_s_waitcnt(0);
        unsigned nloc = b.st[0], nx = b.st[1];
        if (nloc == 0u) { xcd_barrier_complete(bar, b.x, nloc, nx); b.st[0] = nloc; b.st[1] = nx; }
        const unsigned old = xb_add(&bar[XB_XSUB(b.x)], 1u);
        const unsigned gen = old / nloc;
        if (old + 1u == (gen + 1u) * nloc) {
            __builtin_amdgcn_fence(__ATOMIC_RELEASE, "agent");
            asm volatile("s_waitcnt vmcnt(0)" ::: "memory");
            const unsigned og = xb_add(&bar[XB_TOP], 1u);
            const unsigned tg = og / nx;
            if (og + 1u == (tg + 1u) * nx) xb_add(&bar[XB_TOPGEN], 1u);
            else XB_SPIN(xb_ld(&bar[XB_TOPGEN]) == tg, bar);
            __builtin_amdgcn_fence(__ATOMIC_ACQUIRE, "agent");
            xb_add(&bar[XB_XGEN(b.x)], 1u);
            asm volatile("s_waitcnt vmcnt(0)" ::: "memory");
        } else {
            XB_SPIN(xb_ld(&bar[XB_XGEN(b.x)]) == gen, bar);
            __builtin_amdgcn_fence(__ATOMIC_ACQUIRE, "agent");
            asm volatile("s_waitcnt vmcnt(0)" ::: "memory");
        }
    }
    __syncthreads();
}

struct Args { const float* in[15]; float* out; unsigned char* ws; float invf[8]; };

__global__ void __launch_bounds__(NWAVES * 64, 2) fwd_mega(Args args) {
    extern __shared__ __attribute__((aligned(16))) unsigned char lds_raw[];
    LAS unsigned char* lds = (LAS unsigned char*)lds_raw;
    cg::grid_group grid = cg::this_grid();
    const int tid = threadIdx.x, lane = tid & 63, wave = __builtin_amdgcn_readfirstlane(tid >> 6);
    const int G = gridDim.x, bx = blockIdx.x;
    const int vcu = (G % 8 == 0) ? (bx % 8) * (G / 8) + bx / 8 : bx;
    const int gw = vcu * NWAVES + wave, NGW = G * NWAVES;
    unsigned char* ws = args.ws;
    const float* x = args.in[0]; const float* cin = args.in[1]; const float* w_ada = args.in[2]; const float* b_ada = args.in[3]; const float* w_in = args.in[4];
    const float* b_forget = args.in[5]; const float* g_qn_moba = args.in[6]; const float* g_kn_moba = args.in[7]; const float* g_qn_fox = args.in[8]; const float* g_kn_fox = args.in[9];
    const float* g_out_moba = args.in[10]; const float* g_out_fox = args.in[11]; const float* w_out = args.in[12]; const float* w_ff1 = args.in[13]; const float* w_ff2 = args.in[14];
    float* mod = (float*)(ws + OFF_MOD); float* kmean = (float*)(ws + OFF_KMEAN); float* ssqo = (float*)(ws + OFF_SSQO); float* ssq2 = (float*)(ws + OFF_SSQ2);
    float* gains4 = (float*)(ws + WS_GAINS); float* rope = (float*)(ws + WS_ROPE); float* logf_ = (float*)(ws + WS_LOGF); float* cum = (float*)(ws + WS_CUM);
    bf16* Win_t = (bf16*)(ws + WS_WIN); bf16* Wout_t = (bf16*)(ws + WS_WOUT); bf16* W1_t = (bf16*)(ws + WS_W1); bf16* W2_t = (bf16*)(ws + WS_W2);
    bf16* XN = (bf16*)(ws + WS_XN); bf16* QKV = (bf16*)(ws + WS_QKV); bf16* OB = (bf16*)(ws + WS_O); float* X1 = (float*)(ws + WS_X1); bf16* HB = (bf16*)(ws + WS_H);
    volatile LAS unsigned* MISC = (volatile LAS unsigned*)(lds + MISC_OFF);
    if (tid < 64) MISC[tid] = 0u;
    __syncthreads();
    XcdBarrier xbar = xcd_barrier_post((unsigned*)(ws + WS_CTL) + CW_BAR, MISC + 8);
#define GRID_BAR() xcd_barrier(xbar)

#ifndef NO_P0A
    {
        LAS float* sc = (LAS float*)(lds + XOFF);
        for (int i = tid; i < 4096; i += NWAVES * 64) { const float v = cin[i]; sc[i] = v / (1.f + __expf(-v)); }
        __syncthreads();
        for (int it = gw; it < 1536; it += NGW) {
            const int cb = it % 96, kc = it / 96, col = 64 * cb + lane;
            float a0 = 0.f, a1 = 0.f, a2 = 0.f, a3 = 0.f;
#pragma unroll 8
            for (int k = 64 * kc; k < 64 * kc + 64; ++k) { const float w = w_ada[(size_t)k * 6144 + col]; a0 += sc[k] * w; a1 += sc[1024 + k] * w; a2 += sc[2048 + k] * w; a3 += sc[3072 + k] * w; }
            if (kc == 0) { const float bb = b_ada[col]; a0 += bb; a1 += bb; a2 += bb; a3 += bb; }
            atomicAdd(mod + col, a0); atomicAdd(mod + 6144 + col, a1); atomicAdd(mod + 2 * 6144 + col, a2); atomicAdd(mod + 3 * 6144 + col, a3);
        }
        if (bx == 0 && tid < 256) { const float* gsrc = (tid < 64) ? g_qn_moba : (tid < 128) ? g_kn_moba : (tid < 192) ? g_qn_fox : g_kn_fox; gains4[tid] = gsrc[tid & 63]; }
        LAS float* scr = (LAS float*)(lds + wave * 16384);
        constexpr int I_IN = 16 * 96, I_O = 16 * 32, I_1 = 16 * 128, I_2 = 64 * 32, NITEMS = I_IN + I_O + I_1 + I_2;
        for (int it = gw; it < NITEMS; it += NGW) {
            int r = it;
            if (r < I_IN) { transpose_item(w_in, INW, 96, D, Win_t, scr, r, lane, nullptr, nullptr); continue; } r -= I_IN;
            if (r < I_O) { transpose_item(w_out, D, 32, D, Wout_t, scr, r, lane, g_out_moba, g_out_fox); continue; } r -= I_O;
            if (r < I_1) { transpose_item(w_ff1, FF, 128, D, W1_t, scr, r, lane, nullptr, nullptr); continue; } r -= I_1;
            transpose_item(w_ff2, D, 32, FF, W2_t, scr, r, lane, nullptr, nullptr);
        }
        for (int i = (vcu * NWAVES * 64) + tid; i < 4096 * 8; i += G * NWAVES * 64) { const int t = i >> 3, j = i & 7; float c, s; cossin_acc((float)t * args.invf[j], c, s); rope[t * 16 + j] = c; rope[t * 16 + 8 + j] = s; }
    }
#endif
    grid.sync();

#ifndef NO_P0B
    {
        LAS float* wf = (LAS float*)lds;
        for (int i = tid; i < 8192; i += NWAVES * 64) { const int k = i >> 3, hh = i & 7; wf[hh * 1024 + k] = w_in[(size_t)k * INW + 3072 + hh]; }
        __syncthreads();
        for (int m = gw; m < M; m += NGW) {
            const int b = m >> 12, t = m & 4095; const float* mb = mod + (size_t)b * 6144;
            const f32x4* xr = (const f32x4*)(x + (size_t)m * D) + lane;
            f32x4 v[4]; float s = 0.f;
#pragma unroll
            for (int j = 0; j < 4; ++j) { v[j] = xr[64 * j]; s += (v[j].x * v[j].x + v[j].y * v[j].y) + (v[j].z * v[j].z + v[j].w * v[j].w); }
            const float rs = 1.0f / sqrtf(wave_sum(s) * (1.f / D) + EPS);
            float fl[8];
#pragma unroll
            for (int hh = 0; hh < 8; ++hh) fl[hh] = 0.f;
            unsigned long long* o8 = (unsigned long long*)(XN + (size_t)m * D) + lane;
#pragma unroll
            for (int j = 0; j < 4; ++j) { const int col = 4 * lane + 256 * j;
                const f32x4 sh = *(const f32x4*)(mb + col), scl = *(const f32x4*)(mb + 1024 + col);
                const f32x4 hv = v[j] * rs * (scl + 1.0f) + sh;
                o8[64 * j] = (unsigned long long)pk2(hv.x, hv.y) | ((unsigned long long)pk2(hv.z, hv.w) << 32);
#pragma unroll
                for (int hh = 0; hh < 8; ++hh) { const f32x4 w = *(const LAS f32x4*)(wf + hh * 1024 + col); fl[hh] += (hv.x * w.x + hv.y * w.y) + (hv.z * w.z + hv.w * w.w); } }
#pragma unroll
            for (int hh = 0; hh < 8; ++hh) fl[hh] = wave_sum(fl[hh]);
            float mine = fl[0];
#pragma unroll
            for (int hh = 1; hh < 8; ++hh) mine = (lane == hh) ? fl[hh] : mine;
            if (lane < 8) { const float z = mine + b_forget[lane]; const float ls = fminf(z, 0.f) - log1pf(__expf(-fabsf(z))); logf_[(size_t)(b * 8 + lane) * SEQ + t] = ls; }
        }
    }
#endif
    GRID_BAR();

#ifndef NO_P1
    {
        if (bx < 32) {
            LAS float* wt = (LAS float*)(lds + XOFF);
            const float* src = logf_ + (size_t)bx * SEQ + tid * 8;
            const f32x4 a = *(const f32x4*)src, b2 = *(const f32x4*)(src + 4);
            float p[8]; p[0] = a.x; p[1] = p[0] + a.y; p[2] = p[1] + a.z; p[3] = p[2] + a.w; p[4] = p[3] + b2.x; p[5] = p[4] + b2.y; p[6] = p[5] + b2.z; p[7] = p[6] + b2.w;
            float incl = p[7];
#pragma unroll
            for (int o = 1; o < 64; o <<= 1) { const float up = __shfl_up(incl, o); if (lane >= o) incl += up; }
            if (lane == 63) wt[wave] = incl;
            __syncthreads();
            float base = incl - p[7];
            for (int w = 0; w < wave; ++w) base += wt[w];
            float* dst = cum + (size_t)bx * SEQ + tid * 8;
            f32x4 o0, o1; o0.x = (base + p[0]) * LOG2E; o0.y = (base + p[1]) * LOG2E; o0.z = (base + p[2]) * LOG2E; o0.w = (base + p[3]) * LOG2E;
            o1.x = (base + p[4]) * LOG2E; o1.y = (base + p[5]) * LOG2E; o1.z = (base + p[6]) * LOG2E; o1.w = (base + p[7]) * LOG2E;
            *(f32x4*)dst = o0; *(f32x4*)(dst + 4) = o1;
            __syncthreads();
        }
        pg8::Gemm g{XN, Win_t, M, NQKV, D}; pg8::StaticOrder S; S.init(M, NQKV, G, bx);
        pg8::EpiQKV E{QKV, gains4, rope, (LAS float*)(lds + XOFF)};
        pg8::gemm_phase<pg8::EpiQKV, pg8::StaticOrder, true, true>(lds, g, S, E);
        { pg8::Unit u;
          for (int i = 0; S.next(i, u); ++i) if ((u.pn >> 1) == 1) {
              const int cch = tid & 31, rg = tid >> 5;
              float s8[8];
#pragma unroll
              for (int e = 0; e < 8; ++e) s8[e] = 0.f;
#pragma unroll 4
              for (int r = 0; r < 16; ++r) { const v4u v = *(const v4u*)(QKV + (size_t)(u.pm * 256 + rg + 16 * r) * NQKV + u.pn * 256 + cch * 8);
                  s8[0] += __uint_as_float(v.x << 16); s8[1] += __uint_as_float(v.x & 0xffff0000u); s8[2] += __uint_as_float(v.y << 16); s8[3] += __uint_as_float(v.y & 0xffff0000u);
                  s8[4] += __uint_as_float(v.z << 16); s8[5] += __uint_as_float(v.z & 0xffff0000u); s8[6] += __uint_as_float(v.w << 16); s8[7] += __uint_as_float(v.w & 0xffff0000u); }
              LAS float* part = (LAS float*)lds;
#pragma unroll
              for (int e = 0; e < 8; ++e) part[rg * 256 + cch * 8 + e] = s8[e];
              __syncthreads();
              if (tid < 256) { float t = 0.f;
#pragma unroll
                  for (int r = 0; r < 16; ++r) t += part[r * 256 + tid];
                  const int head = (u.pn & 1) * 4 + (tid >> 6), b = u.pm >> 4, blk = u.pm & 15;
                  kmean[((size_t)((b * 8 + head) * 16 + blk)) * 64 + (tid & 63)] = t; }
              __syncthreads();
          } }
    }
#endif
    GRID_BAR();

#ifndef NO_P2
    {
        float bq = fabsf(gains4[128 + lane]), bk = fabsf(gains4[192 + lane]);
#pragma unroll
        for (int o = 1; o < 64; o <<= 1) { bq = fmaxf(bq, __shfl_xor(bq, o)); bk = fmaxf(bk, __shfl_xor(bk, o)); }
        const float fox_thr = 2.0f * (8.0f * LOG2E * bq * bk * 1.02f) + 40.0f;
        unsigned* qctr = (unsigned*)(ws + WS_CTL) + CW_QUEUE;
        LAS int* uq = (LAS int*)(lds + att::L_T0 + 16);
        for (;;) {
            if (tid == 0) *uq = (int)atomicAdd(qctr, 1u);
            __syncthreads();
            const int u = *uq;
            __syncthreads();
            if (u >= 1024) break;
            const int v = u & 511, qb = 15 - (v >> 5), bh = v & 31;
            if (u >= 512) att::attn_unit<true>(bh >> 3, bh & 7, qb, QKV, cum, kmean, OB, ssqo, lds, fox_thr); else att::attn_unit<false>(bh >> 3, bh & 7, qb, QKV, cum, kmean, OB, ssqo, lds, fox_thr);
        }
    }
#endif
    GRID_BAR();

#ifndef NO_P3
    {
        pg8::Gemm g{OB, Wout_t, M, D, D}; pg8::StaticOrder S; S.init(M, D, G, bx);
        LAS float* tab = (LAS float*)(lds + XOFF);
        pg8::Unit u0;
        if (S.next(0, u0)) {
            if (tid < 256) { const int row = u0.pm * 256 + tid; const float rm = 1.0f / sqrtf(ssqo[row] * (1.f / 512.f) + EPS), rf = 1.0f / sqrtf(ssqo[16384 + row] * (1.f / 512.f) + EPS);
                tab[tid] = rm / rf; tab[256 + tid] = rf; }
        }
        __syncthreads();
        pg8::EpiOut E{x, X1, mod + 2048, ssq2, tab};
        pg8::gemm_phase<pg8::EpiOut, pg8::StaticOrder, false, true>(lds, g, S, E);
    }
#endif
    GRID_BAR();

#ifndef NO_P3B
    {
        for (int m = gw; m < M; m += NGW) {
            const int b = m >> 12; const float* mb = mod + (size_t)b * 6144;
            const f32x4* xr = (const f32x4*)(X1 + (size_t)m * D) + lane;
            const float rs = 1.0f / sqrtf(ssq2[m] * (1.f / D) + EPS);
            unsigned long long* o8 = (unsigned long long*)(XN + (size_t)m * D) + lane;
#pragma unroll
            for (int j = 0; j < 4; ++j) { const int col = 4 * lane + 256 * j;
                const f32x4 sh = *(const f32x4*)(mb + 3072 + col), scl = *(const f32x4*)(mb + 4096 + col);
                const f32x4 hv = xr[64 * j] * rs * (scl + 1.0f) + sh;
                o8[64 * j] = (unsigned long long)pk2(hv.x, hv.y) | ((unsigned long long)pk2(hv.z, hv.w) << 32); }
        }
    }
#endif
    GRID_BAR();

#ifndef NO_P4
    {
        pg8::Gemm g{XN, W1_t, M, FF, D}; pg8::StaticOrder S; S.init(M, FF, G, bx);
        pg8::EpiRelu2 E{HB, FF};
        pg8::gemm_phase<pg8::EpiRelu2, pg8::StaticOrder, true, true>(lds, g, S, E);
    }
#endif
    GRID_BAR();

#ifndef NO_P5
    {
        pg8::Gemm g{HB, W2_t, M, D, FF}; pg8::StaticOrder S; S.init(M, D, G, bx);
        pg8::EpiFinal E{X1, args.out, mod + 5120};
        pg8::gemm_phase<pg8::EpiFinal, pg8::StaticOrder, false, true>(lds, g, S, E);
    }
#endif
}

extern "C" void kernel_launch(void* const* d_in, const int* in_sizes, int n_in, void* d_out, int out_size, void* d_ws, size_t ws_size, hipStream_t stream) {
    static int grid = 0;
    if (grid == 0) {
        if (n_in != 15 || out_size != M * D || ws_size < WS_END) { fprintf(stderr, "kernel_launch: unexpected problem (n_in %d out %d ws %zu)\n", n_in, out_size, ws_size); grid = -1; return; }
        int dev = 0, cus = 0, per_cu = 0;
        hipGetDevice(&dev); hipDeviceGetAttribute(&cus, hipDeviceAttributeMultiprocessorCount, dev);
        if (hipFuncSetAttribute((const void*)fwd_mega, hipFuncAttributeMaxDynamicSharedMemorySize, LDS_BYTES) != hipSuccess) { fprintf(stderr, "kernel_launch: hipFuncSetAttribute failed\n"); grid = -1; return; }
        if (hipOccupancyMaxActiveBlocksPerMultiprocessor(&per_cu, (const void*)fwd_mega, NWAVES * 64, LDS_BYTES) != hipSuccess || per_cu < 1) { fprintf(stderr, "kernel_launch: occupancy query says %d\n", per_cu); per_cu = 1; }
        (void)hipGetLastError();
        grid = cus * per_cu;
        fprintf(stderr, "kernel_launch: grid %d (cus %d per_cu %d)\n", grid, cus, per_cu);
    }
    if (grid < 0) return;
    hipMemsetAsync((char*)d_ws + WS_CTL, 0, CTL_ZERO_BYTES, stream);
    Args a{};
    for (int i = 0; i < 15; ++i) a.in[i] = (const float*)d_in[i];
    a.out = (float*)d_out; a.ws = (unsigned char*)d_ws;
    for (int j = 0; j < 8; ++j) a.invf[j] = powf(500000.0f, -(float)(2 * j) / 16.0f);
    void* kargs[] = {&a};
    hipError_t e = hipLaunchCooperativeKernel((const void*)fwd_mega, dim3(grid), dim3(NWAVES * 64), kargs, LDS_BYTES, stream);
    if (e != hipSuccess) fprintf(stderr, "kernel_launch: cooperative launch failed: %s (grid %d)\n", hipGetErrorString(e), grid);
}
```
